# Optimizing an MI355X kernel written in HIP

```python
import math
import jax
import jax.numpy as jnp
from jax import lax
import numpy as np

D_MODEL = 1024
BATCH = 8
SEQ = 2048
DEPTH = 2

MEM_LEN = 256
HEAD_DIM = 64
MIX_WIDTH = 512
ROPE_THETA = 10000.0
NORM_EPS = 1e-6
NEG_INF = -1e30

SSD_HEADS = 8
SSD_INNER = SSD_HEADS * HEAD_DIM
SSD_GROUPS = 2
SSD_STATE = 64
SSD_CONV = 4
SSD_CONV_DIM = SSD_INNER + 2 * SSD_GROUPS * SSD_STATE
SSD_CHUNK = 128

RET_HEADS = 8
RET_DIM = RET_HEADS * HEAD_DIM
RET_CHUNK = 128

MOBA_HEADS = 8
MOBA_DIM = MOBA_HEADS * HEAD_DIM
MOBA_BLOCK = 256
MOBA_TOPK = 3
MOBA_QCHUNK = 32

DIL_HEADS = 8
DIL_DIM = DIL_HEADS * HEAD_DIM
DIL_PATTERNS = ((128, 1), (512, 4), (2048, 16))

N_BRANCHES = 4

X_HEADS = 4
X_HEAD_DIM = D_MODEL // X_HEADS

PEER_HEADS = 8
PEER_NKEYS = 128
PEER_EXPERTS = PEER_NKEYS * PEER_NKEYS
PEER_QDIM = 256
PEER_TOPK = 16
PEER_TCHUNK = 128

IN_SIZES = (SSD_INNER, SSD_CONV_DIM, SSD_HEADS,
            RET_DIM, RET_DIM, RET_DIM, RET_DIM,
            MOBA_DIM, MOBA_DIM, MOBA_DIM,
            DIL_DIM, DIL_DIM, DIL_DIM,
            N_BRANCHES * D_MODEL)
IN_DIM = sum(IN_SIZES)

kernel_name = 'hybrid_gated_ssd_ret_moba_dilated_peer'


def _split_points():
    pts, acc = [], 0
    for size in IN_SIZES[:-1]:
        acc += size
        pts.append(acc)
    return pts


def rms_norm(x, gain):
    xf = x.astype(jnp.float32)
    y = xf * lax.rsqrt(jnp.mean(xf * xf, axis=-1, keepdims=True) + NORM_EPS)
    return (y * gain.astype(jnp.float32)).astype(x.dtype)


def rope(t):
    seq, dh = t.shape[1], t.shape[-1]
    half = dh // 2
    inv_freq = ROPE_THETA ** (-jnp.arange(half, dtype=jnp.float32) / half)
    ang = jnp.arange(seq, dtype=jnp.float32)[:, None] * inv_freq[None, :]
    cos = jnp.cos(ang)[None, :, None, :]
    sin = jnp.sin(ang)[None, :, None, :]
    tf = t.astype(jnp.float32)
    t1, t2 = tf[..., :half], tf[..., half:]
    return jnp.concatenate([t1 * cos - t2 * sin, t2 * cos + t1 * sin], axis=-1).astype(t.dtype)


def softmax_stats(s):
    m = jnp.max(s, axis=-1, keepdims=True)
    e = jnp.exp(s - m)
    l = jnp.sum(e, axis=-1, keepdims=True)
    return e / l, (m + jnp.log(l))[..., 0]


def causal_dwconv(x, w, b):
    k, c = w.shape
    xp = jnp.pad(x, ((0, 0), (k - 1, 0), (0, 0)))
    y = lax.conv_general_dilated(xp, w[:, None, :].astype(x.dtype), window_strides=(1,), padding='VALID',
                                 dimension_numbers=('NWC', 'WIO', 'NWC'), feature_group_count=c)
    return y + b.astype(x.dtype)


def ssd_mixer(z, xbc, dt_raw, conv_w, conv_b, dt_bias, a_log, d_skip, norm_gain):
    bsz, seq, _ = z.shape
    nh, p, n, lc = SSD_HEADS, HEAD_DIM, SSD_STATE, SSD_CHUNK
    nc = seq // lc
    xbc = jax.nn.silu(causal_dwconv(xbc, conv_w, conv_b))
    xs, bm, cm = jnp.split(xbc, [SSD_INNER, SSD_INNER + SSD_GROUPS * n], axis=-1)
    rep = nh // SSD_GROUPS
    xs = xs.reshape(bsz, seq, nh, p)
    bm = jnp.repeat(bm.reshape(bsz, seq, SSD_GROUPS, n), rep, axis=2)
    cm = jnp.repeat(cm.reshape(bsz, seq, SSD_GROUPS, n), rep, axis=2)
    dt = jax.nn.softplus(dt_raw.astype(jnp.float32) + dt_bias.astype(jnp.float32))
    log_a = dt * -jnp.exp(a_log.astype(jnp.float32))
    xdt = (xs * dt[..., None]).reshape(bsz, nc, lc, nh, p)
    bc = bm.reshape(bsz, nc, lc, nh, n)
    cc = cm.reshape(bsz, nc, lc, nh, n)
    acum = jnp.cumsum(log_a.reshape(bsz, nc, lc, nh), axis=2)
    tri = jnp.tril(jnp.ones((lc, lc), dtype=bool))[None, None, :, :, None]
    seg = acum[:, :, :, None, :] - acum[:, :, None, :, :]
    decay = jnp.exp(jnp.where(tri, seg, -jnp.inf))
    scores = jnp.einsum('bclhn,bcshn->bclsh', cc, bc) * decay
    y_diag = jnp.einsum('bclsh,bcshp->bclhp', scores, xdt)
    to_end = jnp.exp(acum[:, :, -1:, :] - acum)
    chunk_states = jnp.einsum('bclhn,bclh,bclhp->bchpn', bc, to_end, xdt)
    chunk_decay = jnp.exp(acum[:, :, -1, :])

    def step(state, inp):
        st, dec = inp
        return state * dec[:, :, None, None] + st, state

    init = jnp.zeros((bsz, nh, p, n), chunk_states.dtype)
    _, prev = lax.scan(step, init, (jnp.moveaxis(chunk_states, 1, 0), jnp.moveaxis(chunk_decay, 1, 0)))
    prev = jnp.moveaxis(prev, 0, 1)
    y_off = jnp.einsum('bclhn,bchpn,bclh->bclhp', cc, prev, jnp.exp(acum))
    y = (y_diag + y_off).reshape(bsz, seq, nh, p) + xs * d_skip.astype(jnp.float32)[:, None]
    y = y.reshape(bsz, seq, SSD_INNER)
    return rms_norm(y * jax.nn.silu(z.astype(jnp.float32)), norm_gain).astype(z.dtype)


def retention_mixer(q, k, v, g, norm_gain):
    bsz, seq, _ = q.shape
    nh, dh, lc = RET_HEADS, HEAD_DIM, RET_CHUNK
    nc = seq // lc
    q = rope(q.reshape(bsz, seq, nh, dh))
    k = rope(k.reshape(bsz, seq, nh, dh)) * dh ** -0.5
    v = v.reshape(bsz, seq, nh, dh)
    log_gamma = jnp.log1p(-jnp.exp2(-5.0 - jnp.arange(nh, dtype=jnp.float32)))
    idx = jnp.arange(lc, dtype=jnp.float32)
    rel = idx[:, None] - idx[None, :]
    dmat = jnp.where((rel >= 0)[..., None], jnp.exp(jnp.maximum(rel, 0.0)[..., None] * log_gamma), 0.0)
    qc = q.reshape(bsz, nc, lc, nh, dh)
    kc = k.reshape(bsz, nc, lc, nh, dh)
    vc = v.reshape(bsz, nc, lc, nh, dh)
    inner = jnp.einsum('bclhd,bcshd->bclsh', qc, kc) * dmat
    y_inner = jnp.einsum('bclsh,bcshe->bclhe', inner, vc)
    zeta = jnp.exp((lc - 1.0 - idx)[:, None] * log_gamma)
    chunk_states = jnp.einsum('bcshd,sh,bcshe->bchde', kc, zeta, vc)
    chunk_decay = jnp.exp(lc * log_gamma)

    def step(state, st):
        return state * chunk_decay[None, :, None, None] + st, state

    init = jnp.zeros((bsz, nh, dh, dh), chunk_states.dtype)
    _, prev = lax.scan(step, init, jnp.moveaxis(chunk_states, 1, 0))
    prev = jnp.moveaxis(prev, 0, 1)
    xi = jnp.exp((idx + 1.0)[:, None] * log_gamma)
    y_cross = jnp.einsum('bclhd,bchde,lh->bclhe', qc, prev, xi)
    y = (y_inner + y_cross).astype(jnp.float32).reshape(bsz, seq, nh, dh)
    mu = jnp.mean(y, axis=-1, keepdims=True)
    var = jnp.mean(jnp.square(y - mu), axis=-1, keepdims=True)
    y = ((y - mu) * lax.rsqrt(var + NORM_EPS)).reshape(bsz, seq, RET_DIM) * norm_gain.astype(jnp.float32)
    return (jax.nn.silu(g.astype(jnp.float32)) * y).astype(g.dtype)


def moba_mixer(q, k, v):
    bsz, seq, _ = q.shape
    nh, dh, blk = MOBA_HEADS, HEAD_DIM, MOBA_BLOCK
    nb = -(-seq // blk)
    sp = nb * blk
    scale = dh ** -0.5

    def heads_first(t):
        t = jnp.pad(t, ((0, 0), (0, sp - seq), (0, 0), (0, 0)))
        return t.transpose(0, 2, 1, 3)

    q = heads_first(rope(q.reshape(bsz, seq, nh, dh)))
    k = heads_first(rope(k.reshape(bsz, seq, nh, dh)))
    v = heads_first(v.reshape(bsz, seq, nh, dh))
    qb = q.reshape(bsz, nh, nb, blk, dh)
    kb = k.reshape(bsz, nh, nb, blk, dh)
    vb = v.reshape(bsz, nh, nb, blk, dh)
    tri = jnp.tril(jnp.ones((blk, blk), dtype=bool))
    s_own = jnp.einsum('bhnid,bhnjd->bhnij', qb, kb).astype(jnp.float32) * scale
    p_own, lse_own = softmax_stats(jnp.where(tri, s_own, NEG_INF))
    o_own = jnp.einsum('bhnij,bhnjd->bhnid', p_own.astype(v.dtype), vb).reshape(bsz, nh, sp, dh)
    lse_own = lse_own.reshape(bsz, nh, sp)
    n_sel = min(MOBA_TOPK, nb - 1)
    if n_sel == 0:
        out = o_own
    else:
        k_mean = jnp.mean(kb, axis=3)
        gate = jnp.einsum('bhtd,bhnd->bhtn', q, k_mean).astype(jnp.float32)
        q_block = jnp.arange(sp) // blk
        past = jnp.arange(nb)[None, :] < q_block[:, None]
        _, sel = lax.top_k(jnp.where(past, gate, -jnp.inf), n_sel)
        valid = sel < q_block[:, None]
        nq = sp // MOBA_QCHUNK

        def by_chunk(t):
            return jnp.moveaxis(t.reshape(bsz, nh, nq, MOBA_QCHUNK, *t.shape[3:]), 2, 0)

        gather_blocks = jax.vmap(jax.vmap(lambda blocks, ids: blocks[ids]))

        def attend(args):
            qc, selc, validc = args
            ksel = gather_blocks(kb, selc)
            vsel = gather_blocks(vb, selc)
            s = jnp.einsum('bhqd,bhqnjd->bhqnj', qc, ksel).astype(jnp.float32) * scale
            s = jnp.where(validc[..., None], s, NEG_INF).reshape(bsz, nh, MOBA_QCHUNK, n_sel * blk)
            p, lse = softmax_stats(s)
            o = jnp.einsum('bhqm,bhqmd->bhqd', p.astype(v.dtype),
                           vsel.reshape(bsz, nh, MOBA_QCHUNK, n_sel * blk, dh))
            return o, lse

        o_past, lse_past = lax.map(attend, (by_chunk(q), by_chunk(sel), by_chunk(valid)))
        o_past = jnp.moveaxis(o_past, 0, 2).reshape(bsz, nh, sp, dh)
        lse_past = jnp.moveaxis(lse_past, 0, 2).reshape(bsz, nh, sp)
        w = jax.nn.softmax(jnp.stack([lse_own, lse_past], axis=-1), axis=-1)
        out = w[..., :1] * o_own + w[..., 1:] * o_past
    return out[:, :, :seq].transpose(0, 2, 1, 3).reshape(bsz, seq, MOBA_DIM).astype(v.dtype)


def dilated_group(q, k, v, window, dil):
    bsz, nh, seq, dh = q.shape
    n_off = window // dil
    sd = -(-seq // dil) * dil
    ln = sd // dil
    nblk = -(-ln // n_off)
    lp = nblk * n_off

    def to_sub(t):
        t = jnp.pad(t, ((0, 0), (0, 0), (0, sd - seq), (0, 0)))
        t = t.reshape(bsz, nh, ln, dil, dh).transpose(0, 1, 3, 2, 4)
        return jnp.pad(t, ((0, 0), (0, 0), (0, 0), (0, lp - ln), (0, 0)))

    def to_band(t):
        t = jnp.pad(to_sub(t), ((0, 0), (0, 0), (0, 0), (n_off, 0), (0, 0)))
        t = t.reshape(bsz, nh, dil, nblk + 1, n_off, dh)
        return jnp.concatenate([t[:, :, :, :-1], t[:, :, :, 1:]], axis=4)

    qb = to_sub(q).reshape(bsz, nh, dil, nblk, n_off, dh)
    kb, vb = to_band(k), to_band(v)
    s = jnp.einsum('bhrnid,bhrnjd->bhrnij', qb, kb).astype(jnp.float32) * dh ** -0.5
    i = jnp.arange(n_off)[:, None]
    j = jnp.arange(2 * n_off)[None, :]
    steps = i + n_off - j
    key_pos = (jnp.arange(nblk)[:, None, None] - 1) * n_off + j[None]
    mask = (steps >= 0) & (steps <= n_off) & (key_pos >= 0)
    p, lse = softmax_stats(jnp.where(mask, s, NEG_INF))
    o = jnp.einsum('bhrnij,bhrnjd->bhrnid', p.astype(v.dtype), vb)
    o = o.reshape(bsz, nh, dil, lp, dh)[:, :, :, :ln].transpose(0, 1, 3, 2, 4).reshape(bsz, nh, sd, dh)[:, :, :seq]
    lse = lse.reshape(bsz, nh, dil, lp)[..., :ln].transpose(0, 1, 3, 2).reshape(bsz, nh, sd)[..., :seq]
    return o, lse


def dilated_mixer(q, k, v):
    bsz, seq, _ = q.shape
    q = rope(q.reshape(bsz, seq, DIL_HEADS, HEAD_DIM)).transpose(0, 2, 1, 3)
    k = rope(k.reshape(bsz, seq, DIL_HEADS, HEAD_DIM)).transpose(0, 2, 1, 3)
    v = v.reshape(bsz, seq, DIL_HEADS, HEAD_DIM).transpose(0, 2, 1, 3)
    groups = [dilated_group(q, k, v, w, d) for (w, d) in DIL_PATTERNS]
    wts = jax.nn.softmax(jnp.stack([lse for _, lse in groups], axis=-1), axis=-1)
    out = jnp.einsum('bhsg,gbhsd->bhsd', wts.astype(v.dtype), jnp.stack([o for o, _ in groups]))
    return out.transpose(0, 2, 1, 3).reshape(bsz, seq, DIL_DIM).astype(v.dtype)


def cross_attention(h, mem, w_q, w_kv, w_o):
    bsz, seq, _ = h.shape
    q = (h @ w_q).reshape(bsz, seq, X_HEADS, X_HEAD_DIM)
    k, v = jnp.split(mem @ w_kv, 2, axis=-1)
    k = k.reshape(bsz, -1, X_HEADS, X_HEAD_DIM)
    v = v.reshape(bsz, -1, X_HEADS, X_HEAD_DIM)
    s = jnp.einsum('bshd,bmhd->bhsm', q, k).astype(jnp.float32) * X_HEAD_DIM ** -0.5
    p = jax.nn.softmax(s, axis=-1).astype(v.dtype)
    o = jnp.einsum('bhsm,bmhd->bshd', p, v).reshape(bsz, seq, D_MODEL)
    return o @ w_o


def peer_ffn(h, w_q, sub_keys, expert_u, expert_v):
    bsz, seq, d = h.shape
    t = bsz * seq
    x = h.reshape(t, d)
    q = (x @ w_q).reshape(t, PEER_HEADS, 2, PEER_QDIM // 2)
    s = jnp.einsum('thpd,hpkd->thpk', q, sub_keys).astype(jnp.float32)
    s_top, i_top = lax.top_k(s, PEER_TOPK)
    cand_s = (s_top[:, :, 0, :, None] + s_top[:, :, 1, None, :]).reshape(t, PEER_HEADS, PEER_TOPK * PEER_TOPK)
    cand_i = (i_top[:, :, 0, :, None] * PEER_NKEYS + i_top[:, :, 1, None, :]).reshape(t, PEER_HEADS, PEER_TOPK * PEER_TOPK)
    best_s, pos = lax.top_k(cand_s, PEER_TOPK)
    expert_idx = jnp.take_along_axis(cand_i, pos, axis=-1)
    gate = jax.nn.softmax(best_s, axis=-1)
    nt = t // PEER_TCHUNK

    def apply(args):
        xc, ic, gc = args
        u = expert_u[ic]
        vv = expert_v[ic]
        act = jax.nn.gelu(jnp.einsum('td,thkd->thk', xc, u).astype(jnp.float32), approximate=False)
        return jnp.einsum('thk,thkd->td', (act * gc).astype(vv.dtype), vv)

    y = lax.map(apply, (x.reshape(nt, PEER_TCHUNK, d),
                        expert_idx.reshape(nt, PEER_TCHUNK, PEER_HEADS, PEER_TOPK),
                        gate.reshape(nt, PEER_TCHUNK, PEER_HEADS, PEER_TOPK)))
    return y.reshape(bsz, seq, d).astype(h.dtype)


def setup_inputs(seed: int = 0) -> dict:
    key = jax.random.key(seed)
    ks = jax.random.split(key, 23)
    f32 = jnp.float32

    def nrm(k, shape, scale):
        return jax.random.normal(k, shape, f32) * scale

    def gain(k, shape):
        return 1.0 + 0.02 * jax.random.normal(k, shape, f32)

    dt0 = jnp.exp(jax.random.uniform(ks[6], (DEPTH, SSD_HEADS), f32, math.log(1e-3), math.log(1e-1)))
    dt_bias = dt0 + jnp.log(-jnp.expm1(-dt0))
    return {
        'x': nrm(ks[0], (BATCH, SEQ, D_MODEL), 1.0),
        'mem': nrm(ks[1], (BATCH, MEM_LEN, D_MODEL), 1.0),
        'mix_norm': gain(ks[2], (DEPTH, D_MODEL)),
        'w_in': nrm(ks[3], (DEPTH, D_MODEL, IN_DIM), D_MODEL ** -0.5),
        'ssd_conv_w': nrm(ks[4], (DEPTH, SSD_CONV, SSD_CONV_DIM), SSD_CONV ** -0.5),
        'ssd_conv_b': nrm(ks[5], (DEPTH, SSD_CONV_DIM), 0.01),
        'ssd_dt_bias': dt_bias,
        'ssd_a_log': jnp.log(jax.random.uniform(ks[7], (DEPTH, SSD_HEADS), f32, 1.0, 16.0)),
        'ssd_d': 1.0 + 0.1 * jax.random.normal(ks[8], (DEPTH, SSD_HEADS), f32),
        'ssd_norm': gain(ks[9], (DEPTH, SSD_INNER)),
        'ret_norm': gain(ks[10], (DEPTH, RET_DIM)),
        'w_branch': nrm(ks[11], (DEPTH, N_BRANCHES, MIX_WIDTH, D_MODEL), MIX_WIDTH ** -0.5),
        'w_out': nrm(ks[12], (DEPTH, D_MODEL, D_MODEL), D_MODEL ** -0.5),
        'x_norm': gain(ks[13], (DEPTH, D_MODEL)),
        'w_xq': nrm(ks[14], (DEPTH, D_MODEL, D_MODEL), D_MODEL ** -0.5),
        'w_xkv': nrm(ks[15], (DEPTH, D_MODEL, 2 * D_MODEL), D_MODEL ** -0.5),
        'w_xo': nrm(ks[16], (DEPTH, D_MODEL, D_MODEL), D_MODEL ** -0.5),
        'ffn_norm': gain(ks[17], (DEPTH, D_MODEL)),
        'w_pq': nrm(ks[18], (DEPTH, D_MODEL, PEER_HEADS * PEER_QDIM), D_MODEL ** -0.5),
        'peer_sub_keys': nrm(ks[19], (DEPTH, PEER_HEADS, 2, PEER_NKEYS, PEER_QDIM // 2), (PEER_QDIM // 2) ** -0.5),
        'peer_u': nrm(ks[20], (DEPTH, PEER_EXPERTS, D_MODEL), D_MODEL ** -0.5),
        'peer_v': nrm(ks[21], (DEPTH, PEER_EXPERTS, D_MODEL), (PEER_HEADS * PEER_TOPK) ** -0.5),
        'final_norm': gain(ks[22], (D_MODEL,)),
    }


def reference(x, mem, mix_norm, w_in, ssd_conv_w, ssd_conv_b, ssd_dt_bias, ssd_a_log, ssd_d, ssd_norm,
              ret_norm, w_branch, w_out, x_norm, w_xq, w_xkv, w_xo, ffn_norm, w_pq, peer_sub_keys,
              peer_u, peer_v, final_norm):
    bsz, seq, _ = x.shape
    pts = _split_points()
    h = x
    for layer in range(DEPTH):
        hn = rms_norm(h, mix_norm[layer])
        (z, xbc, dt_raw, rq, rk, rv, rg, mq, mk, mv, dq, dk, dv,
         gate_logits) = jnp.split(hn @ w_in[layer], pts, axis=-1)
        ys = (ssd_mixer(z, xbc, dt_raw, ssd_conv_w[layer], ssd_conv_b[layer], ssd_dt_bias[layer],
                        ssd_a_log[layer], ssd_d[layer], ssd_norm[layer]),
              retention_mixer(rq, rk, rv, rg, ret_norm[layer]),
              moba_mixer(mq, mk, mv),
              dilated_mixer(dq, dk, dv))
        gates = jax.nn.sigmoid(gate_logits.reshape(bsz, seq, N_BRANCHES, D_MODEL))
        merged = sum(gates[:, :, i] * (ys[i] @ w_branch[layer, i]) for i in range(N_BRANCHES))
        h = h + merged @ w_out[layer]
        h = h + cross_attention(rms_norm(h, x_norm[layer]), mem, w_xq[layer], w_xkv[layer], w_xo[layer])
        h = h + peer_ffn(rms_norm(h, ffn_norm[layer]), w_pq[layer], peer_sub_keys[layer],
                         peer_u[layer], peer_v[layer])
    return rms_norm(h, final_norm)
```

```cpp
#include <hip/hip_runtime.h>
#include <hip/hip_bf16.h>
#include <hip/hip_cooperative_groups.h>
#include <cstdio>
namespace cg = cooperative_groups;

typedef unsigned short u16;
using bf16x8 = __attribute__((ext_vector_type(8))) short;
using f32x4 = __attribute__((ext_vector_type(4))) float;
using u32x4 = __attribute__((ext_vector_type(4))) unsigned;

constexpr int T_ = 16384, S_ = 2048, B_ = 8, D_ = 1024;
constexpr int IN_DIM = 10504;
constexpr int NPROJ = 6400;
constexpr int C_Z = 0, C_XBC = 512, C_RQ = 1280, C_RK = 1792, C_RV = 2304, C_RG = 2816;
constexpr int C_MQ = 3328, C_MK = 3840, C_MV = 4352, C_DQ = 4864, C_DK = 5376, C_DV = 5888;
constexpr int NEXP = 16384;

constexpr size_t MiB = 1048576;
constexpr size_t OFF_H = 0;
constexpr size_t OFF_HN = 64 * MiB;
constexpr size_t OFF_PROJ = 96 * MiB;
constexpr size_t OFF_XQ = OFF_PROJ;
constexpr size_t OFF_XO = OFF_PROJ + 32 * MiB;
constexpr size_t OFF_PQ = OFF_PROJ + 64 * MiB;
constexpr size_t OFF_YS = 296 * MiB;
constexpr size_t OFF_MERGED = 360 * MiB;
constexpr size_t OFF_W = 392 * MiB;
constexpr size_t W_IN = 0;
constexpr size_t W_G = W_IN + (size_t)6400 * 1024 * 2;
constexpr size_t W_B = W_G + (size_t)4096 * 1024 * 2;
constexpr size_t W_O = W_B + (size_t)4 * 1024 * 512 * 2;
constexpr size_t W_XQ = W_O + (size_t)1024 * 1024 * 2;
constexpr size_t W_XKV = W_XQ + (size_t)1024 * 1024 * 2;
constexpr size_t W_XO = W_XKV + (size_t)2048 * 1024 * 2;
constexpr size_t W_PQ = W_XO + (size_t)1024 * 1024 * 2;
constexpr size_t W_LAYER = W_PQ + (size_t)2048 * 1024 * 2;
constexpr size_t OFF_XKV = OFF_W + 2 * W_LAYER;
constexpr size_t OFF_SELI = OFF_XKV + 16 * MiB;
constexpr size_t OFF_SELG = OFF_SELI + 8 * MiB;
constexpr size_t OFF_DT = OFF_SELG + 8 * MiB;
constexpr size_t OFF_ROPE = OFF_DT + (size_t)T_ * 8 * 4;
constexpr size_t OFF_WDT = OFF_ROPE + (size_t)2048 * 64 * 4;
constexpr size_t OFF_KMEAN = OFF_WDT + (size_t)2 * 8 * 1024 * 4;
constexpr size_t OFF_MEMB = OFF_KMEAN + (size_t)8 * 8 * 8 * 64 * 4;
constexpr size_t OFF_END = OFF_MEMB + (size_t)2048 * 1024 * 2;
static_assert(OFF_END <= 512 * MiB, "workspace overflow");

struct Params {
    const float *x, *mem, *mix_norm, *w_in, *conv_w, *conv_b, *dt_bias, *a_log, *ssd_d, *ssd_norm, *ret_norm,
        *w_branch, *w_out, *x_norm, *w_xq, *w_xkv, *w_xo, *ffn_norm, *w_pq, *sub_keys, *peer_u, *peer_v, *final_norm;
    float* out;
    char* ws;
};

struct Ctx { int tid, bid, nb; };

__device__ __forceinline__ u16 f2bf(float f) {
    unsigned u = __float_as_uint(f);
    u += 0x7fffu + ((u >> 16) & 1u);
    return (u16)(u >> 16);
}
__device__ __forceinline__ float bf2f(u16 b) { return __uint_as_float(((unsigned)b) << 16); }
__device__ __forceinline__ float wsum(float v) {
#pragma unroll
    for (int o = 32; o > 0; o >>= 1) v += __shfl_xor(v, o);
    return v;
}
__device__ __forceinline__ float wmax(float v) {
#pragma unroll
    for (int o = 32; o > 0; o >>= 1) v = fmaxf(v, __shfl_xor(v, o));
    return v;
}
__device__ __forceinline__ float siluf(float x) { return x / (1.f + __expf(-x)); }
__device__ __forceinline__ float sigmf(float x) { return 1.f / (1.f + __expf(-x)); }
__device__ __forceinline__ float softplusf(float x) { return fmaxf(x, 0.f) + log1pf(expf(-fabsf(x))); }

constexpr int SMEM_BYTES = 36864;

__device__ __forceinline__ void convT_job(const Ctx& X, const float* __restrict__ src, int ld, int c0, int ncols, int K, u16* __restrict__ dst,
                          int ldd, float* sm, int bid, int nb) {
    const int tilesN = ncols / 64, tilesK = K / 64;
    const int tid = X.tid;
    for (int t = bid; t < tilesN * tilesK; t += nb) {
        const int tk = t / tilesN, tn = t % tilesN;
        __syncthreads();
        for (int e = tid; e < 4096; e += 256) {
            int r = e >> 6, c = e & 63;
            sm[r * 65 + c] = src[(size_t)(tk * 64 + r) * ld + c0 + tn * 64 + c];
        }
        __syncthreads();
        for (int e = tid; e < 4096; e += 256) {
            int n = e >> 6, k = e & 63;
            dst[(size_t)(tn * 64 + n) * ldd + tk * 64 + k] = f2bf(sm[k * 65 + n]);
        }
    }
}

__device__ __forceinline__ void phase_prologue(const Ctx& X, const Params& p, char* smem) {
    const int bid = X.bid, nb = X.nb, tid = X.tid;
    float* sm = (float*)smem;
    char* ws = p.ws;
    for (int L = 0; L < 2; ++L) {
        char* wl = ws + OFF_W + L * W_LAYER;
        const float* win = p.w_in + (size_t)L * 1024 * IN_DIM;
        convT_job(X, win, IN_DIM, 0, 1280, 1024, (u16*)(wl + W_IN), 1024, sm, bid, nb);
        convT_job(X, win, IN_DIM, 1288, 5120, 1024, (u16*)(wl + W_IN) + (size_t)1280 * 1024, 1024, sm, bid, nb);
        convT_job(X, win, IN_DIM, 6408, 4096, 1024, (u16*)(wl + W_G), 1024, sm, bid, nb);
        for (int i = 0; i < 4; ++i)
            convT_job(X, p.w_branch + ((size_t)L * 4 + i) * 512 * 1024, 1024, 0, 1024, 512,
                      (u16*)(wl + W_B) + (size_t)i * 1024 * 512, 512, sm, bid, nb);
        convT_job(X, p.w_out + (size_t)L * 1024 * 1024, 1024, 0, 1024, 1024, (u16*)(wl + W_O), 1024, sm, bid, nb);
        convT_job(X, p.w_xq + (size_t)L * 1024 * 1024, 1024, 0, 1024, 1024, (u16*)(wl + W_XQ), 1024, sm, bid, nb);
        convT_job(X, p.w_xkv + (size_t)L * 1024 * 2048, 2048, 0, 2048, 1024, (u16*)(wl + W_XKV), 1024, sm, bid, nb);
        convT_job(X, p.w_xo + (size_t)L * 1024 * 1024, 1024, 0, 1024, 1024, (u16*)(wl + W_XO), 1024, sm, bid, nb);
        convT_job(X, p.w_pq + (size_t)L * 1024 * 2048, 2048, 0, 2048, 1024, (u16*)(wl + W_PQ), 1024, sm, bid, nb);
        float* wdt = (float*)(ws + OFF_WDT) + L * 8 * 1024;
        for (int e = bid * 256 + tid; e < 8 * 1024; e += nb * 256) {
            int j = e >> 10, k = e & 1023;
            wdt[e] = win[(size_t)k * IN_DIM + 1280 + j];
        }
    }
    float* rope = (float*)(ws + OFF_ROPE);
    for (int e = bid * 256 + tid; e < 2048 * 32; e += nb * 256) {
        int pos = e >> 5, i = e & 31;
        float inv = powf(10000.f, -(float)i / 32.f);
        float ang = (float)pos * inv;
        rope[e * 2] = cosf(ang);
        rope[e * 2 + 1] = sinf(ang);
    }
    {
        const float4* xs = (const float4*)p.x;
        float4* hd = (float4*)(ws + OFF_H);
        for (size_t e = (size_t)bid * 256 + tid; e < (size_t)T_ * 256; e += (size_t)nb * 256) hd[e] = xs[e];
        u16* mb = (u16*)(ws + OFF_MEMB);
        for (int e = bid * 256 + tid; e < 2048 * 1024; e += nb * 256) mb[e] = f2bf(p.mem[e]);
    }
}

__device__ __forceinline__ void phase_norm(const Ctx& X, const Params& p, const float* __restrict__ gain, const float* __restrict__ wdt) {
    const int lane = X.tid & 63, wid = X.tid >> 6;
    const float* h = (const float*)(p.ws + OFF_H);
    u16* hn = (u16*)(p.ws + OFF_HN);
    float* dt = (float*)(p.ws + OFF_DT);
    for (int t = X.bid * 4 + wid; t < T_; t += X.nb * 4) {
        const float4* hr = (const float4*)(h + (size_t)t * 1024);
        float4 v[4];
        float ss = 0.f;
#pragma unroll
        for (int i = 0; i < 4; ++i) {
            v[i] = hr[lane + i * 64];
            ss += v[i].x * v[i].x + v[i].y * v[i].y + v[i].z * v[i].z + v[i].w * v[i].w;
        }
        ss = wsum(ss);
        const float r = rsqrtf(ss * (1.f / 1024.f) + 1e-6f);
#pragma unroll
        for (int i = 0; i < 4; ++i) {
            float4 g = ((const float4*)gain)[lane + i * 64];
            v[i].x *= r * g.x; v[i].y *= r * g.y; v[i].z *= r * g.z; v[i].w *= r * g.w;
            ushort4 o;
            o.x = f2bf(v[i].x); o.y = f2bf(v[i].y); o.z = f2bf(v[i].z); o.w = f2bf(v[i].w);
            ((ushort4*)(hn + (size_t)t * 1024))[lane + i * 64] = o;
        }
        if (wdt) {
#pragma unroll
            for (int j = 0; j < 8; ++j) {
                float a = 0.f;
#pragma unroll
                for (int i = 0; i < 4; ++i) {
                    float4 w = ((const float4*)(wdt + j * 1024))[lane + i * 64];
                    a += v[i].x * w.x + v[i].y * w.y + v[i].z * w.z + v[i].w * w.w;
                }
                a = wsum(a);
                if (lane == 0) dt[t * 8 + j] = a;
            }
        }
    }
}

__device__ __forceinline__ void phase_final(const Ctx& X, const Params& p) {
    const int lane = X.tid & 63, wid = X.tid >> 6;
    const float* h = (const float*)(p.ws + OFF_H);
    for (int t = X.bid * 4 + wid; t < T_; t += X.nb * 4) {
        const float4* hr = (const float4*)(h + (size_t)t * 1024);
        float4 v[4];
        float ss = 0.f;
#pragma unroll
        for (int i = 0; i < 4; ++i) {
            v[i] = hr[lane + i * 64];
            ss += v[i].x * v[i].x + v[i].y * v[i].y + v[i].z * v[i].z + v[i].w * v[i].w;
        }
        ss = wsum(ss);
        const float r = rsqrtf(ss * (1.f / 1024.f) + 1e-6f);
#pragma unroll
        for (int i = 0; i < 4; ++i) {
            float4 g = ((const float4*)p.final_norm)[lane + i * 64];
            float4 o;
            o.x = v[i].x * r * g.x; o.y = v[i].y * r * g.y; o.z = v[i].z * r * g.z; o.w = v[i].w * r * g.w;
            ((float4*)(p.out + (size_t)t * 1024))[lane + i * 64] = o;
        }
    }
}

constexpr int LDT = 72;
template <int BM, int BN>
__device__ __forceinline__ void gemm_core(const Ctx& X, const u16* __restrict__ Ag, int lda, const u16* __restrict__ Bg, int ldb,
                                          int K, f32x4 (&acc)[BM / 32][BN / 32], u16* sA, u16* sB) {
    constexpr int NA = BM / 32, NB = BN / 32;
    const int tid = X.tid, lane = tid & 63, wid = tid >> 6;
    const int wr = wid >> 1, wc = wid & 1, fr = lane & 15, fq = lane >> 4;
    u32x4 ra[NA], rb[NB];
#pragma unroll
    for (int i = 0; i < NA; ++i) {
        int ch = tid + i * 256;
        ra[i] = *(const u32x4*)(Ag + (size_t)(ch >> 3) * lda + (ch & 7) * 8);
    }
#pragma unroll
    for (int i = 0; i < NB; ++i) {
        int ch = tid + i * 256;
        rb[i] = *(const u32x4*)(Bg + (size_t)(ch >> 3) * ldb + (ch & 7) * 8);
    }
    for (int k0 = 0; k0 < K; k0 += 64) {
        __syncthreads();
#pragma unroll
        for (int i = 0; i < NA; ++i) {
            int ch = tid + i * 256;
            *(u32x4*)(sA + (ch >> 3) * LDT + (ch & 7) * 8) = ra[i];
        }
#pragma unroll
        for (int i = 0; i < NB; ++i) {
            int ch = tid + i * 256;
            *(u32x4*)(sB + (ch >> 3) * LDT + (ch & 7) * 8) = rb[i];
        }
        __syncthreads();
        if (k0 + 64 < K) {
#pragma unroll
            for (int i = 0; i < NA; ++i) {
                int ch = tid + i * 256;
                ra[i] = *(const u32x4*)(Ag + (size_t)(ch >> 3) * lda + k0 + 64 + (ch & 7) * 8);
            }
#pragma unroll
            for (int i = 0; i < NB; ++i) {
                int ch = tid + i * 256;
                rb[i] = *(const u32x4*)(Bg + (size_t)(ch >> 3) * ldb + k0 + 64 + (ch & 7) * 8);
            }
        }
#pragma unroll
        for (int ks = 0; ks < 2; ++ks) {
            bf16x8 af[NA], bfr[NB];
#pragma unroll
            for (int m = 0; m < NA; ++m)
                af[m] = *(const bf16x8*)(sA + (wr * (BM / 2) + m * 16 + fr) * LDT + ks * 32 + fq * 8);
#pragma unroll
            for (int n = 0; n < NB; ++n)
                bfr[n] = *(const bf16x8*)(sB + (wc * (BN / 2) + n * 16 + fr) * LDT + ks * 32 + fq * 8);
#pragma unroll
            for (int m = 0; m < NA; ++m)
#pragma unroll
                for (int n = 0; n < NB; ++n)
                    acc[m][n] = __builtin_amdgcn_mfma_f32_16x16x32_bf16(af[m], bfr[n], acc[m][n], 0, 0, 0);
        }
    }
}

enum { EPI_PROJ = 0, EPI_BF16 = 1, EPI_RESID = 2 };

template <int EPI>
__device__ __forceinline__ void phase_gemm(const Ctx& X, const Params& p, const u16* __restrict__ A, int lda, const u16* __restrict__ Bt, int M,
                           int N, int K, void* Cout, int ldc, char* smem) {
    u16* sA = (u16*)smem;
    u16* sB = sA + 128 * LDT;
    const int nM = M / 128, nN = N / 128;
    const int tid = X.tid, lane = tid & 63, wid = tid >> 6;
    const int wr = wid >> 1, wc = wid & 1, fr = lane & 15, fq = lane >> 4;
    const float* rope = (const float*)(p.ws + OFF_ROPE);
    for (int tile = X.bid; tile < nM * nN; tile += X.nb) {
        const int tm = tile % nM, tn = tile / nM;
        f32x4 acc[4][4];
#pragma unroll
        for (int m = 0; m < 4; ++m)
#pragma unroll
            for (int n = 0; n < 4; ++n) acc[m][n] = f32x4{0.f, 0.f, 0.f, 0.f};
        gemm_core<128, 128>(X, A + (size_t)tm * 128 * lda, lda, Bt + (size_t)tn * 128 * K, K, K, acc, sA, sB);
        const int row0 = tm * 128 + wr * 64, col0 = tn * 128 + wc * 64;
        if (EPI == EPI_PROJ) {
            u16* C = (u16*)Cout;
            int mode = 0;
            if ((col0 >= C_RQ && col0 < C_RK) || (col0 >= C_MQ && col0 < C_MV) || (col0 >= C_DQ && col0 < C_DV)) mode = 1;
            if (col0 >= C_RK && col0 < C_RV) mode = 2;
            if (mode == 0) {
#pragma unroll
                for (int m = 0; m < 4; ++m)
#pragma unroll
                    for (int n = 0; n < 4; ++n)
#pragma unroll
                        for (int j = 0; j < 4; ++j)
                            C[(size_t)(row0 + m * 16 + fq * 4 + j) * ldc + col0 + n * 16 + fr] = f2bf(acc[m][n][j]);
            } else {
                const float sc = (mode == 2) ? 0.125f : 1.f;
#pragma unroll
                for (int m = 0; m < 4; ++m)
#pragma unroll
                    for (int j = 0; j < 4; ++j) {
                        const int row = row0 + m * 16 + fq * 4 + j;
                        const int pos = row & (S_ - 1);
#pragma unroll
                        for (int n = 0; n < 2; ++n) {
                            const int d = n * 16 + fr;
                            const float2 cs = *(const float2*)(rope + ((size_t)pos * 32 + d) * 2);
                            const float t1 = acc[m][n][j], t2 = acc[m][n + 2][j];
                            C[(size_t)row * ldc + col0 + d] = f2bf((t1 * cs.x - t2 * cs.y) * sc);
                            C[(size_t)row * ldc + col0 + d + 32] = f2bf((t2 * cs.x + t1 * cs.y) * sc);
                        }
                    }
            }
        } else if (EPI == EPI_BF16) {
            u16* C = (u16*)Cout;
#pragma unroll
            for (int m = 0; m < 4; ++m)
#pragma unroll
                for (int n = 0; n < 4; ++n)
#pragma unroll
                    for (int j = 0; j < 4; ++j)
                        C[(size_t)(row0 + m * 16 + fq * 4 + j) * ldc + col0 + n * 16 + fr] = f2bf(acc[m][n][j]);
        } else {
            float* C = (float*)Cout;
#pragma unroll
            for (int m = 0; m < 4; ++m)
#pragma unroll
                for (int n = 0; n < 4; ++n)
#pragma unroll
                    for (int j = 0; j < 4; ++j) {
                        float* q = &C[(size_t)(row0 + m * 16 + fq * 4 + j) * ldc + col0 + n * 16 + fr];
                        *q = *q + acc[m][n][j];
                    }
        }
    }
}

__device__ __forceinline__ void phase_merge(const Ctx& X, const Params& p, int L, char* smem) {
    u16* sA = (u16*)smem;
    u16* sB = sA + 128 * LDT;
    const char* wl = p.ws + OFF_W + L * W_LAYER;
    const u16* hn = (const u16*)(p.ws + OFF_HN);
    const u16* ys = (const u16*)(p.ws + OFF_YS);
    u16* merged = (u16*)(p.ws + OFF_MERGED);
    const int nM = T_ / 128, nN = 1024 / 64;
    const int tid = X.tid, lane = tid & 63, wid = tid >> 6;
    const int wr = wid >> 1, wc = wid & 1, fr = lane & 15, fq = lane >> 4;
    for (int tile = X.bid; tile < nM * nN; tile += X.nb) {
        const int tm = tile % nM, tn = tile / nM;
        f32x4 accm[4][2];
#pragma unroll
        for (int m = 0; m < 4; ++m)
#pragma unroll
            for (int n = 0; n < 2; ++n) accm[m][n] = f32x4{0.f, 0.f, 0.f, 0.f};
        for (int i = 0; i < 4; ++i) {
            f32x4 accg[4][2], accb[4][2];
#pragma unroll
            for (int m = 0; m < 4; ++m)
#pragma unroll
                for (int n = 0; n < 2; ++n) {
                    accg[m][n] = f32x4{0.f, 0.f, 0.f, 0.f};
                    accb[m][n] = f32x4{0.f, 0.f, 0.f, 0.f};
                }
            gemm_core<128, 64>(X, hn + (size_t)tm * 128 * 1024, 1024,
                               (const u16*)(wl + W_G) + (size_t)(i * 1024 + tn * 64) * 1024, 1024, 1024, accg, sA, sB);
            gemm_core<128, 64>(X, ys + ((size_t)i * T_ + (size_t)tm * 128) * 512, 512,
                               (const u16*)(wl + W_B) + ((size_t)i * 1024 + tn * 64) * 512, 512, 512, accb, sA, sB);
#pragma unroll
            for (int m = 0; m < 4; ++m)
#pragma unroll
                for (int n = 0; n < 2; ++n)
#pragma unroll
                    for (int j = 0; j < 4; ++j) accm[m][n][j] += sigmf(accg[m][n][j]) * accb[m][n][j];
        }
        const int row0 = tm * 128 + wr * 64, col0 = tn * 64 + wc * 32;
#pragma unroll
        for (int m = 0; m < 4; ++m)
#pragma unroll
            for (int n = 0; n < 2; ++n)
#pragma unroll
                for (int j = 0; j < 4; ++j)
                    merged[(size_t)(row0 + m * 16 + fq * 4 + j) * 1024 + col0 + n * 16 + fr] = f2bf(accm[m][n][j]);
    }
}

__device__ __forceinline__ void phase_kmean(const Ctx& X, const Params& p) {
    const u16* proj = (const u16*)(p.ws + OFF_PROJ);
    float* km = (float*)(p.ws + OFF_KMEAN);
    for (int e = X.bid * 256 + X.tid; e < 8 * 8 * 8 * 64; e += X.nb * 256) {
        const int d = e & 63, n = (e >> 6) & 7, h = (e >> 9) & 7, b = e >> 12;
        float a = 0.f;
        const u16* kp = proj + ((size_t)b * S_ + n * 256) * NPROJ + C_MK + h * 64 + d;
        for (int j = 0; j < 256; ++j) a += bf2f(kp[(size_t)j * NPROJ]);
        km[e] = a * (1.f / 256.f);
    }
}

__device__ __forceinline__ void attn_tile64(const float (&q)[64], const u16* __restrict__ kb, const u16* __restrict__ vb,
                                            int pos, float scale, float& m, float& l, float& o, int lane) {
    float s = -1e30f;
    if (pos >= 0) {
        const uint4* kr = (const uint4*)(kb + (size_t)pos * NPROJ);
        float a = 0.f;
#pragma unroll
        for (int c = 0; c < 8; ++c) {
            uint4 w = kr[c];
            a += q[c * 8 + 0] * __uint_as_float(w.x << 16) + q[c * 8 + 1] * __uint_as_float(w.x & 0xffff0000u);
            a += q[c * 8 + 2] * __uint_as_float(w.y << 16) + q[c * 8 + 3] * __uint_as_float(w.y & 0xffff0000u);
            a += q[c * 8 + 4] * __uint_as_float(w.z << 16) + q[c * 8 + 5] * __uint_as_float(w.z & 0xffff0000u);
            a += q[c * 8 + 6] * __uint_as_float(w.w << 16) + q[c * 8 + 7] * __uint_as_float(w.w & 0xffff0000u);
        }
        s = a * scale;
    }
    const float tmax = wmax(s);
    if (tmax < -1e29f) return;
    const float mn = fmaxf(m, tmax);
    const float alpha = __expf(m - mn);
    const float pr = (pos >= 0) ? __expf(s - mn) : 0.f;
    l = l * alpha + wsum(pr);
    o *= alpha;
#pragma unroll 8
    for (int j = 0; j < 64; ++j) {
        const int pj = __shfl(pos, j);
        const float pp = __shfl(pr, j);
        if (pj >= 0) o += pp * bf2f(vb[(size_t)pj * NPROJ + lane]);
    }
    m = mn;
}

__device__ __forceinline__ void load_q64(float (&q)[64], const u16* qp) {
#pragma unroll
    for (int c = 0; c < 8; ++c) {
        uint4 w = ((const uint4*)qp)[c];
        q[c * 8 + 0] = __uint_as_float(w.x << 16); q[c * 8 + 1] = __uint_as_float(w.x & 0xffff0000u);
        q[c * 8 + 2] = __uint_as_float(w.y << 16); q[c * 8 + 3] = __uint_as_float(w.y & 0xffff0000u);
        q[c * 8 + 4] = __uint_as_float(w.z << 16); q[c * 8 + 5] = __uint_as_float(w.z & 0xffff0000u);
        q[c * 8 + 6] = __uint_as_float(w.w << 16); q[c * 8 + 7] = __uint_as_float(w.w & 0xffff0000u);
    }
}

__device__ __forceinline__ void moba_query(const Params& p, int b, int h, int i, int lane) {
    const u16* proj = (const u16*)(p.ws + OFF_PROJ);
    const u16* base = proj + (size_t)b * S_ * NPROJ;
    float q[64];
    load_q64(q, base + (size_t)i * NPROJ + C_MQ + h * 64);
    const int nq = i >> 8;
    int sel0 = -1, sel1 = -1, sel2 = -1;
    {
        const float* km = (const float*)(p.ws + OFF_KMEAN) + ((size_t)(b * 8 + h) * 8) * 64;
        float g[8];
#pragma unroll
        for (int n = 0; n < 8; ++n) {
            float a = 0.f;
#pragma unroll
            for (int d = 0; d < 64; ++d) a += q[d] * km[n * 64 + d];
            g[n] = (n < nq) ? a : -INFINITY;
        }
#pragma unroll
        for (int r = 0; r < 3; ++r) {
            int bi = -1;
            float bv = -INFINITY;
#pragma unroll
            for (int n = 0; n < 8; ++n)
                if (g[n] > bv) { bv = g[n]; bi = n; }
            if (bi >= 0) {
#pragma unroll
                for (int n = 0; n < 8; ++n)
                    if (n == bi) g[n] = -INFINITY;
            }
            if (r == 0) sel0 = bi; else if (r == 1) sel1 = bi; else sel2 = bi;
        }
    }
    const u16* kb = base + C_MK + h * 64;
    const u16* vb = base + C_MV + h * 64;
    float m = -1e30f, l = 0.f, o = 0.f;
    for (int j0 = nq * 256; j0 <= i; j0 += 64) {
        const int pos = (j0 + lane <= i) ? (j0 + lane) : -1;
        attn_tile64(q, kb, vb, pos, 0.125f, m, l, o, lane);
    }
#pragma unroll
    for (int r = 0; r < 3; ++r) {
        const int sb = (r == 0) ? sel0 : (r == 1) ? sel1 : sel2;
        if (sb >= 0) {
            for (int j0 = sb * 256; j0 < sb * 256 + 256; j0 += 64) attn_tile64(q, kb, vb, j0 + lane, 0.125f, m, l, o, lane);
        }
    }
    u16* ys = (u16*)(p.ws + OFF_YS) + (size_t)2 * T_ * 512;
    ys[((size_t)b * S_ + i) * 512 + h * 64 + lane] = f2bf(o / l);
}

__device__ __forceinline__ void dil_query(const Params& p, int b, int h, int i, int lane) {
    const u16* proj = (const u16*)(p.ws + OFF_PROJ);
    const u16* base = proj + (size_t)b * S_ * NPROJ;
    float q[64];
    load_q64(q, base + (size_t)i * NPROJ + C_DQ + h * 64);
    const u16* kb = base + C_DK + h * 64;
    const u16* vb = base + C_DV + h * 64;
    float m = -1e30f, l = 0.f, o = 0.f;
#pragma unroll
    for (int g = 0; g < 3; ++g) {
        const int dil = (g == 0) ? 1 : (g == 1) ? 4 : 16;
        for (int k0 = 0; k0 <= 128; k0 += 64) {
            const int k = k0 + lane;
            int pos = (k <= 128) ? (i - k * dil) : -1;
            if (pos < 0) pos = -1;
            attn_tile64(q, kb, vb, pos, 0.125f, m, l, o, lane);
        }
    }
    u16* ys = (u16*)(p.ws + OFF_YS) + (size_t)3 * T_ * 512;
    ys[((size_t)b * S_ + i) * 512 + h * 64 + lane] = f2bf(o / l);
}

__device__ __forceinline__ void ssd_item(const Ctx& X, const Params& p, int L, int b, int hg, char* smem) {
    const int lane = X.tid & 63, w = X.tid >> 6;
    const int h = hg * 4 + w, g = h >> 2;
    float* sBC = (float*)smem + w * 128;
    const u16* proj = (const u16*)(p.ws + OFF_PROJ) + (size_t)b * S_ * NPROJ;
    const float* dtr = (const float*)(p.ws + OFF_DT) + (size_t)b * S_ * 8;
    float* tmp = (float*)(p.ws + OFF_MERGED) + (size_t)b * S_ * 512;
    const float* cw = p.conv_w + (size_t)L * 4 * 768;
    const float* cb = p.conv_b + (size_t)L * 768;
    const int cx = h * 64 + lane, cB = 512 + g * 64 + lane, cC = 640 + g * 64 + lane;
    float wx[4], wB[4], wC[4];
#pragma unroll
    for (int k = 0; k < 4; ++k) { wx[k] = cw[k * 768 + cx]; wB[k] = cw[k * 768 + cB]; wC[k] = cw[k * 768 + cC]; }
    const float bx = cb[cx], bB = cb[cB], bC = cb[cC];
    const float dtb = p.dt_bias[L * 8 + h], A = -expf(p.a_log[L * 8 + h]), Dk = p.ssd_d[L * 8 + h];
    float st[64];
#pragma unroll
    for (int n = 0; n < 64; ++n) st[n] = 0.f;
    float x1 = 0.f, x2 = 0.f, x3 = 0.f, B1 = 0.f, B2 = 0.f, B3 = 0.f, C1 = 0.f, C2 = 0.f, C3 = 0.f;
    float nx = bf2f(proj[C_XBC + cx]), nB = bf2f(proj[C_XBC + cB]), nC = bf2f(proj[C_XBC + cC]);
    float nz = bf2f(proj[C_Z + cx]), ndt = dtr[h];
    for (int s = 0; s < S_; ++s) {
        const float x0 = nx, B0 = nB, C0 = nC, z = nz, dtraw = ndt;
        if (s + 1 < S_) {
            const u16* pr = proj + (size_t)(s + 1) * NPROJ;
            nx = bf2f(pr[C_XBC + cx]); nB = bf2f(pr[C_XBC + cB]); nC = bf2f(pr[C_XBC + cC]);
            nz = bf2f(pr[C_Z + cx]); ndt = dtr[(s + 1) * 8 + h];
        }
        const float xs = siluf(bx + wx[0] * x3 + wx[1] * x2 + wx[2] * x1 + wx[3] * x0);
        const float Bv = siluf(bB + wB[0] * B3 + wB[1] * B2 + wB[2] * B1 + wB[3] * B0);
        const float Cv = siluf(bC + wC[0] * C3 + wC[1] * C2 + wC[2] * C1 + wC[3] * C0);
        x3 = x2; x2 = x1; x1 = x0; B3 = B2; B2 = B1; B1 = B0; C3 = C2; C2 = C1; C1 = C0;
        __syncthreads();
        sBC[lane] = Bv;
        sBC[64 + lane] = Cv;
        __syncthreads();
        const float dt = softplusf(dtraw + dtb);
        const float a = __expf(dt * A);
        const float xdt = xs * dt;
        float y = 0.f;
#pragma unroll
        for (int n = 0; n < 64; n += 4) {
            const float4 b4 = *(const float4*)(sBC + n);
            const float4 c4 = *(const float4*)(sBC + 64 + n);
            st[n] = st[n] * a + b4.x * xdt; y += c4.x * st[n];
            st[n + 1] = st[n + 1] * a + b4.y * xdt; y += c4.y * st[n + 1];
            st[n + 2] = st[n + 2] * a + b4.z * xdt; y += c4.z * st[n + 2];
            st[n + 3] = st[n + 3] * a + b4.w * xdt; y += c4.w * st[n + 3];
        }
        y += Dk * xs;
        tmp[(size_t)s * 512 + cx] = y * siluf(z);
    }
}

__device__ __forceinline__ void ret_item(const Ctx& X, const Params& p, int L, int b, int hg, char* smem) {
    const int lane = X.tid & 63, w = X.tid >> 6;
    const int h = hg * 4 + w;
    float* sQK = (float*)smem + w * 128;
    const u16* proj = (const u16*)(p.ws + OFF_PROJ) + (size_t)b * S_ * NPROJ;
    u16* ys = (u16*)(p.ws + OFF_YS) + (size_t)1 * T_ * 512 + (size_t)b * S_ * 512;
    const float gamma = 1.f - exp2f(-5.f - (float)h);
    const float gn = p.ret_norm[L * 512 + h * 64 + lane];
    float st[64];
#pragma unroll
    for (int d = 0; d < 64; ++d) st[d] = 0.f;
    const int c = h * 64 + lane;
    float nq = bf2f(proj[C_RQ + c]), nk = bf2f(proj[C_RK + c]), nv = bf2f(proj[C_RV + c]), ng = bf2f(proj[C_RG + c]);
    for (int s = 0; s < S_; ++s) {
        const float q = nq, k = nk, v = nv, gg = ng;
        if (s + 1 < S_) {
            const u16* pr = proj + (size_t)(s + 1) * NPROJ;
            nq = bf2f(pr[C_RQ + c]); nk = bf2f(pr[C_RK + c]); nv = bf2f(pr[C_RV + c]); ng = bf2f(pr[C_RG + c]);
        }
        __syncthreads();
        sQK[lane] = q;
        sQK[64 + lane] = k;
        __syncthreads();
        float y = 0.f;
#pragma unroll
        for (int d = 0; d < 64; d += 4) {
            const float4 q4 = *(const float4*)(sQK + d);
            const float4 k4 = *(const float4*)(sQK + 64 + d);
            st[d] = st[d] * gamma + k4.x * v; y += q4.x * st[d];
            st[d + 1] = st[d + 1] * gamma + k4.y * v; y += q4.y * st[d + 1];
            st[d + 2] = st[d + 2] * gamma + k4.z * v; y += q4.z * st[d + 2];
            st[d + 3] = st[d + 3] * gamma + k4.w * v; y += q4.w * st[d + 3];
        }
        const float mu = wsum(y) * (1.f / 64.f);
        const float dv = y - mu;
        const float var = wsum(dv * dv) * (1.f / 64.f);
        const float yn = dv * rsqrtf(var + 1e-6f) * gn;
        ys[(size_t)s * 512 + c] = f2bf(siluf(gg) * yn);
    }
}

__device__ __forceinline__ void phase_mixers(const Ctx& X, const Params& p, int L, char* smem) {
    const int lane = X.tid & 63, w = X.tid >> 6;
    const int nAtt = T_ * 8 / 4;
    const int total = 32 + 2 * nAtt;
    for (int it = X.bid; it < total; it += X.nb) {
        if (it < 16) {
            ssd_item(X, p, L, it >> 1, it & 1, smem);
        } else if (it < 32) {
            ret_item(X, p, L, (it - 16) >> 1, it & 1, smem);
        } else {
            int a = it - 32;
            const int kind = a >= nAtt;
            if (kind) a -= nAtt;
            const int wq = a * 4 + w;
            const int h = wq & 7, ti = wq >> 3;
            const int b = ti >> 11, i = ti & (S_ - 1);
            if (kind == 0) moba_query(p, b, h, i, lane);
            else dil_query(p, b, h, i, lane);
        }
    }
}

__device__ __forceinline__ void phase_ssdnorm(const Ctx& X, const Params& p, int L) {
    const int lane = X.tid & 63, wid = X.tid >> 6;
    const float* tmp = (const float*)(p.ws + OFF_MERGED);
    u16* ys = (u16*)(p.ws + OFF_YS);
    const float* gain = p.ssd_norm + L * 512;
    for (int t = X.bid * 4 + wid; t < T_; t += X.nb * 4) {
        float v[8];
        float ss = 0.f;
#pragma unroll
        for (int i = 0; i < 8; ++i) { v[i] = tmp[(size_t)t * 512 + lane + i * 64]; ss += v[i] * v[i]; }
        ss = wsum(ss);
        const float r = rsqrtf(ss * (1.f / 512.f) + 1e-6f);
#pragma unroll
        for (int i = 0; i < 8; ++i) ys[(size_t)t * 512 + lane + i * 64] = f2bf(v[i] * r * gain[lane + i * 64]);
    }
}

__device__ __forceinline__ void phase_xattn(const Ctx& X, const Params& p, int L) {
    const int lane = X.tid & 63, wid = X.tid >> 6;
    const u16* xq = (const u16*)(p.ws + OFF_XQ);
    const u16* kv = (const u16*)(p.ws + OFF_XKV) + (size_t)L * 2048 * 2048;
    u16* xo = (u16*)(p.ws + OFF_XO);
    for (int it = X.bid * 4 + wid; it < T_ * 4; it += X.nb * 4) {
        const int hx = it & 3, t = it >> 2, b = t >> 11;
        float q[4];
        {
            const ushort4 qq = *(const ushort4*)(xq + (size_t)t * 1024 + hx * 256 + lane * 4);
            q[0] = bf2f(qq.x); q[1] = bf2f(qq.y); q[2] = bf2f(qq.z); q[3] = bf2f(qq.w);
        }
        const u16* kb = kv + (size_t)b * 256 * 2048 + hx * 256 + lane * 4;
        const u16* vb = kv + (size_t)b * 256 * 2048 + 1024 + hx * 256 + lane * 4;
        float sc[4] = {0.f, 0.f, 0.f, 0.f};
#pragma unroll
        for (int gI = 0; gI < 4; ++gI) {
            for (int mm = 0; mm < 64; ++mm) {
                const ushort4 kk = *(const ushort4*)(kb + (size_t)(gI * 64 + mm) * 2048);
                float a = q[0] * bf2f(kk.x) + q[1] * bf2f(kk.y) + q[2] * bf2f(kk.z) + q[3] * bf2f(kk.w);
                a = wsum(a);
                if (lane == mm) sc[gI] = a * 0.0625f;
            }
        }
        float mx = wmax(fmaxf(fmaxf(sc[0], sc[1]), fmaxf(sc[2], sc[3])));
        float pe[4], ls = 0.f;
#pragma unroll
        for (int gI = 0; gI < 4; ++gI) { pe[gI] = __expf(sc[gI] - mx); ls += pe[gI]; }
        ls = wsum(ls);
        float o[4] = {0.f, 0.f, 0.f, 0.f};
#pragma unroll
        for (int gI = 0; gI < 4; ++gI) {
            for (int mm = 0; mm < 64; ++mm) {
                const float pp = __shfl(pe[gI], mm);
                const ushort4 vv = *(const ushort4*)(vb + (size_t)(gI * 64 + mm) * 2048);
                o[0] += pp * bf2f(vv.x); o[1] += pp * bf2f(vv.y); o[2] += pp * bf2f(vv.z); o[3] += pp * bf2f(vv.w);
            }
        }
        const float inv = 1.f / ls;
        ushort4 oo;
        oo.x = f2bf(o[0] * inv); oo.y = f2bf(o[1] * inv); oo.z = f2bf(o[2] * inv); oo.w = f2bf(o[3] * inv);
        *(ushort4*)(xo + (size_t)t * 1024 + hx * 256 + lane * 4) = oo;
    }
}

__device__ __forceinline__ void wargmax(float& v, int& i) {
#pragma unroll
    for (int o = 32; o > 0; o >>= 1) {
        const float ov = __shfl_xor(v, o);
        const int oi = __shfl_xor(i, o);
        if (ov > v || (ov == v && oi < i)) { v = ov; i = oi; }
    }
}

__device__ __forceinline__ void phase_peer_select(const Ctx& X, const Params& p, int L) {
    const int lane = X.tid & 63, wid = X.tid >> 6;
    const u16* pq = (const u16*)(p.ws + OFF_PQ);
    int* seli = (int*)(p.ws + OFF_SELI);
    float* selg = (float*)(p.ws + OFF_SELG);
    for (int it = X.bid * 4 + wid; it < T_ * 8; it += X.nb * 4) {
        const int hh = it & 7, t = it >> 3;
        const u16* qp = pq + (size_t)t * 2048 + hh * 256;
        float tops[2] = {0.f, 0.f};
        int topi[2] = {0, 0};
#pragma unroll
        for (int pp = 0; pp < 2; ++pp) {
            const float* keys = p.sub_keys + ((size_t)((L * 8 + hh) * 2 + pp) * 128) * 128;
            float s0 = 0.f, s1 = 0.f;
            const float4* k0 = (const float4*)(keys + (size_t)lane * 128);
            const float4* k1 = (const float4*)(keys + (size_t)(lane + 64) * 128);
            for (int d4 = 0; d4 < 32; ++d4) {
                const ushort4 qq = *(const ushort4*)(qp + pp * 128 + d4 * 4);
                const float q0 = bf2f(qq.x), q1 = bf2f(qq.y), q2 = bf2f(qq.z), q3 = bf2f(qq.w);
                const float4 a = k0[d4], bq = k1[d4];
                s0 += q0 * a.x + q1 * a.y + q2 * a.z + q3 * a.w;
                s1 += q0 * bq.x + q1 * bq.y + q2 * bq.z + q3 * bq.w;
            }
            for (int r = 0; r < 16; ++r) {
                float bv;
                int bi;
                if (s0 >= s1) { bv = s0; bi = lane; } else { bv = s1; bi = lane + 64; }
                wargmax(bv, bi);
                if (lane == r) { tops[pp] = bv; topi[pp] = bi; }
                if (bi == lane) s0 = -INFINITY;
                if (bi == lane + 64) s1 = -INFINITY;
            }
        }
        float cs[4];
#pragma unroll
        for (int j = 0; j < 4; ++j) {
            const int c = lane + 64 * j;
            cs[j] = __shfl(tops[0], c >> 4) + __shfl(tops[1], c & 15);
        }
        float bests = 0.f;
        int bestc = 0;
        for (int r = 0; r < 16; ++r) {
            float bv = cs[0];
            int bi = lane;
#pragma unroll
            for (int j = 1; j < 4; ++j)
                if (cs[j] > bv) { bv = cs[j]; bi = lane + 64 * j; }
            wargmax(bv, bi);
            if (lane == r) { bests = bv; bestc = bi; }
#pragma unroll
            for (int j = 0; j < 4; ++j)
                if (bi == lane + 64 * j) cs[j] = -INFINITY;
        }
        const float bmax = __shfl(bests, 0);
        float e = (lane < 16) ? __expf(bests - bmax) : 0.f;
        const float es = wsum(e);
        const int ia = __shfl(topi[0], bestc >> 4);
        const int ib = __shfl(topi[1], bestc & 15);
        if (lane < 16) {
            seli[(size_t)t * 128 + hh * 16 + lane] = ia * 128 + ib;
            selg[(size_t)t * 128 + hh * 16 + lane] = e / es;
        }
    }
}

__device__ __forceinline__ void phase_peer_apply(const Ctx& X, const Params& p, int L) {
    const int lane = X.tid & 63, wid = X.tid >> 6;
    const u16* hn = (const u16*)(p.ws + OFF_HN);
    const int* seli = (const int*)(p.ws + OFF_SELI);
    const float* selg = (const float*)(p.ws + OFF_SELG);
    float* h = (float*)(p.ws + OFF_H);
    const float* U = p.peer_u + (size_t)L * NEXP * 1024;
    const float* V = p.peer_v + (size_t)L * NEXP * 1024;
    for (int t = X.bid * 4 + wid; t < T_; t += X.nb * 4) {
        float4 x[4];
#pragma unroll
        for (int i = 0; i < 4; ++i) {
            const ushort4 xx = ((const ushort4*)(hn + (size_t)t * 1024))[lane + i * 64];
            x[i] = make_float4(bf2f(xx.x), bf2f(xx.y), bf2f(xx.z), bf2f(xx.w));
        }
        float4 y[4];
#pragma unroll
        for (int i = 0; i < 4; ++i) y[i] = make_float4(0.f, 0.f, 0.f, 0.f);
        for (int k = 0; k < 128; ++k) {
            const int e = seli[(size_t)t * 128 + k];
            const float g = selg[(size_t)t * 128 + k];
            const float4* ur = (const float4*)(U + (size_t)e * 1024);
            float a = 0.f;
#pragma unroll
            for (int i = 0; i < 4; ++i) {
                const float4 u = ur[lane + i * 64];
                a += x[i].x * u.x + x[i].y * u.y + x[i].z * u.z + x[i].w * u.w;
            }
            a = wsum(a);
            const float act = 0.5f * a * (1.f + erff(a * 0.70710678118654752f)) * g;
            const float4* vr = (const float4*)(V + (size_t)e * 1024);
#pragma unroll
            for (int i = 0; i < 4; ++i) {
                const float4 v = vr[lane + i * 64];
                y[i].x += act * v.x; y[i].y += act * v.y; y[i].z += act * v.z; y[i].w += act * v.w;
            }
        }
        float4* hr = (float4*)(h + (size_t)t * 1024);
#pragma unroll
        for (int i = 0; i < 4; ++i) {
            float4 hv = hr[lane + i * 64];
            hv.x += y[i].x; hv.y += y[i].y; hv.z += y[i].z; hv.w += y[i].w;
            hr[lane + i * 64] = hv;
        }
    }
}

enum { OP_PROLOGUE = 0, OP_XKV, OP_NORM1, OP_GEMM_PROJ, OP_KMEAN, OP_MIXERS, OP_SSDNORM, OP_MERGE, OP_GEMM_OUT, OP_NORM2,
       OP_GEMM_XQ, OP_XATTN, OP_GEMM_XO, OP_NORM3, OP_GEMM_PQ, OP_PSEL, OP_PAPPLY, OP_FINAL };
constexpr int N_PHASES = 2 + 2 * 15 + 1;

__device__ __forceinline__ void run_phase(const Ctx& X, const Params& p, int ph, char* smem) {
    char* ws = p.ws;
    int op, L = 0;
    if (ph < 2) op = ph;
    else if (ph == N_PHASES - 1) op = OP_FINAL;
    else { L = (ph - 2) / 15; op = OP_NORM1 + (ph - 2) % 15; }
    const char* wl = ws + OFF_W + L * W_LAYER;
    switch (op) {
    case OP_PROLOGUE: phase_prologue(X, p, smem); break;
    case OP_XKV:
        for (int l2 = 0; l2 < 2; ++l2)
            phase_gemm<EPI_BF16>(X, p, (const u16*)(ws + OFF_MEMB), 1024, (const u16*)(ws + OFF_W + l2 * W_LAYER + W_XKV),
                                 2048, 2048, 1024, (u16*)(ws + OFF_XKV) + (size_t)l2 * 2048 * 2048, 2048, smem);
        break;
    case OP_NORM1: phase_norm(X, p, p.mix_norm + L * 1024, (const float*)(ws + OFF_WDT) + L * 8 * 1024); break;
    case OP_GEMM_PROJ:
        phase_gemm<EPI_PROJ>(X, p, (const u16*)(ws + OFF_HN), 1024, (const u16*)(wl + W_IN), T_, NPROJ, 1024, ws + OFF_PROJ,
                             NPROJ, smem);
        break;
    case OP_KMEAN: phase_kmean(X, p); break;
    case OP_MIXERS: phase_mixers(X, p, L, smem); break;
    case OP_SSDNORM: phase_ssdnorm(X, p, L); break;
    case OP_MERGE: phase_merge(X, p, L, smem); break;
    case OP_GEMM_OUT:
        phase_gemm<EPI_RESID>(X, p, (const u16*)(ws + OFF_MERGED), 1024, (const u16*)(wl + W_O), T_, 1024, 1024, ws + OFF_H,
                              1024, smem);
        break;
    case OP_NORM2: phase_norm(X, p, p.x_norm + L * 1024, nullptr); break;
    case OP_GEMM_XQ:
        phase_gemm<EPI_BF16>(X, p, (const u16*)(ws + OFF_HN), 1024, (const u16*)(wl + W_XQ), T_, 1024, 1024, ws + OFF_XQ,
                             1024, smem);
        break;
    case OP_XATTN: phase_xattn(X, p, L); break;
    case OP_GEMM_XO:
        phase_gemm<EPI_RESID>(X, p, (const u16*)(ws + OFF_XO), 1024, (const u16*)(wl + W_XO), T_, 1024, 1024, ws + OFF_H,
                              1024, smem);
        break;
    case OP_NORM3: phase_norm(X, p, p.ffn_norm + L * 1024, nullptr); break;
    case OP_GEMM_PQ:
        phase_gemm<EPI_BF16>(X, p, (const u16*)(ws + OFF_HN), 1024, (const u16*)(wl + W_PQ), T_, 2048, 1024, ws + OFF_PQ,
                             2048, smem);
        break;
    case OP_PSEL: phase_peer_select(X, p, L); break;
    case OP_PAPPLY: phase_peer_apply(X, p, L); break;
    default: phase_final(X, p); break;
    }
}

__global__ void __launch_bounds__(256, 2) mk_kernel(Params p, int ph_lo, int ph_hi) {
    cg::grid_group grid = cg::this_grid();
    __shared__ __attribute__((aligned(16))) char smem[SMEM_BYTES];
#pragma unroll 1
    for (int ph = ph_lo; ph < ph_hi; ++ph) {
        Ctx X;
        X.tid = threadIdx.x; X.bid = blockIdx.x; X.nb = gridDim.x;
        asm volatile("" : "+v"(X.tid));
        asm volatile("" : "+s"(X.bid));
        asm volatile("" : "+s"(X.nb));
        Params q = p;
        {
            long z = 0;
            asm volatile("" : "+s"(z));
            const char** qq = (const char**)&q;
#pragma unroll
            for (int i = 0; i < 25; ++i) qq[i] += z;
        }
        run_phase(X, q, ph, smem);
        if (ph + 1 < ph_hi) grid.sync();
    }
}

extern "C" void kernel_launch(void* const* d_in, const int* in_sizes, int n_in, void* d_out, int out_size, void* d_ws,
                              size_t ws_size, hipStream_t stream) {
    static int grid_blocks = 0;
    if (!grid_blocks) {
        int dev = 0, cus = 0, per_cu = 0;
        (void)hipGetDevice(&dev);
        (void)hipDeviceGetAttribute(&cus, hipDeviceAttributeMultiprocessorCount, dev);
        (void)hipOccupancyMaxActiveBlocksPerMultiprocessor(&per_cu, mk_kernel, 256, 0);
        if (per_cu > 2) per_cu = 2;
        if (per_cu < 1) per_cu = 1;
        grid_blocks = cus * per_cu;
    }
    Params p{};
    const float** pp = (const float**)&p;
    for (int i = 0; i < 23; ++i) pp[i] = (const float*)d_in[i];
    p.out = (float*)d_out;
    p.ws = (char*)d_ws;
    if (ws_size < 512 * MiB) fprintf(stderr, "workspace too small: %zu\n", ws_size);
    int ph_lo = 0, ph_hi = N_PHASES;
    void* args[] = {&p, &ph_lo, &ph_hi};
    hipError_t e = hipLaunchCooperativeKernel((void*)mk_kernel, dim3(grid_blocks), dim3(256), args, 0, stream);
    if (e != hipSuccess) fprintf(stderr, "cooperative launch failed: %s (grid %d)\n", hipGetErrorString(e), grid_blocks);
}
```

```cpp
#include <hip/hip_runtime.h>
#include <hip/hip_bf16.h>
#include <hip/hip_cooperative_groups.h>
#include <cstdio>
namespace cg = cooperative_groups;

typedef unsigned short u16;
using bf16x8 = __attribute__((ext_vector_type(8))) short;
using f32x4 = __attribute__((ext_vector_type(4))) float;
using u32x4 = __attribute__((ext_vector_type(4))) unsigned;

constexpr int T_ = 16384, S_ = 2048, B_ = 8, D_ = 1024;
constexpr int IN_DIM = 10504;
constexpr int NPROJ = 6400;
constexpr int C_Z = 0, C_XBC = 512, C_RQ = 1280, C_RK = 1792, C_RV = 2304, C_RG = 2816;
constexpr int C_MQ = 3328, C_MK = 3840, C_MV = 4352, C_DQ = 4864, C_DK = 5376, C_DV = 5888;
constexpr int NEXP = 16384;

constexpr size_t MiB = 1048576;
constexpr size_t OFF_H = 0;
constexpr size_t OFF_HN = 64 * MiB;
constexpr size_t OFF_PROJ = 96 * MiB;
constexpr size_t OFF_XQ = OFF_PROJ;
constexpr size_t OFF_XO = OFF_PROJ + 32 * MiB;
constexpr size_t OFF_PQ = OFF_PROJ + 64 * MiB;
constexpr size_t OFF_PU = OFF_PROJ + 128 * MiB;
constexpr size_t OFF_PV = OFF_PROJ + 160 * MiB;
constexpr size_t OFF_YS = 296 * MiB;
constexpr size_t OFF_MERGED = 360 * MiB;
constexpr size_t OFF_CONV = OFF_MERGED;
constexpr size_t OFF_DTV = OFF_MERGED + 24 * MiB;
constexpr size_t OFF_ACUM = OFF_DTV + (size_t)T_ * 8 * 4;
constexpr size_t OFF_W = 392 * MiB;
constexpr size_t W_IN = 0;
constexpr size_t W_G = W_IN + (size_t)6400 * 1024 * 2;
constexpr size_t W_B = W_G + (size_t)4096 * 1024 * 2;
constexpr size_t W_O = W_B + (size_t)4 * 1024 * 512 * 2;
constexpr size_t W_XQ = W_O + (size_t)1024 * 1024 * 2;
constexpr size_t W_XKV = W_XQ + (size_t)1024 * 1024 * 2;
constexpr size_t W_XO = W_XKV + (size_t)2048 * 1024 * 2;
constexpr size_t W_PQ = W_XO + (size_t)1024 * 1024 * 2;
constexpr size_t W_LAYER = W_PQ + (size_t)2048 * 1024 * 2;
constexpr size_t OFF_XKV = OFF_W + 2 * W_LAYER;
constexpr size_t OFF_SELI = OFF_XKV + 16 * MiB;
constexpr size_t OFF_SELG = OFF_SELI + 8 * MiB;
constexpr size_t OFF_DT = OFF_SELG + 8 * MiB;
constexpr size_t OFF_ROPE = OFF_DT + (size_t)T_ * 8 * 4;
constexpr size_t OFF_WDT = OFF_ROPE + (size_t)2048 * 64 * 4;
constexpr size_t OFF_KMEAN = OFF_WDT + (size_t)2 * 8 * 1024 * 4;
constexpr size_t OFF_MEMB = OFF_KMEAN + (size_t)8 * 8 * 8 * 64 * 4;
constexpr size_t OFF_BAR = OFF_MEMB + (size_t)2048 * 1024 * 2;
constexpr size_t OFF_KEYS = OFF_BAR + 16384;
constexpr size_t OFF_END = OFF_KEYS + (size_t)2 * 8 * 2 * 128 * 128 * 2;
static_assert(OFF_END <= 512 * MiB, "workspace overflow");

struct Params {
    const float *x, *mem, *mix_norm, *w_in, *conv_w, *conv_b, *dt_bias, *a_log, *ssd_d, *ssd_norm, *ret_norm,
        *w_branch, *w_out, *x_norm, *w_xq, *w_xkv, *w_xo, *ffn_norm, *w_pq, *sub_keys, *peer_u, *peer_v, *final_norm;
    float* out;
    char* ws;
};

struct Ctx { int tid, bid, nb; };

__device__ __forceinline__ u16 f2bf(float f) {
    unsigned u = __float_as_uint(f);
    u += 0x7fffu + ((u >> 16) & 1u);
    return (u16)(u >> 16);
}
__device__ __forceinline__ float bf2f(u16 b) { return __uint_as_float(((unsigned)b) << 16); }
__device__ __forceinline__ float wsum(float v) {
#pragma unroll
    for (int o = 32; o > 0; o >>= 1) v += __shfl_xor(v, o);
    return v;
}
__device__ __forceinline__ float wmax(float v) {
#pragma unroll
    for (int o = 32; o > 0; o >>= 1) v = fmaxf(v, __shfl_xor(v, o));
    return v;
}
__device__ __forceinline__ float siluf(float x) { return x / (1.f + __expf(-x)); }
__device__ __forceinline__ float sigmf(float x) { return 1.f / (1.f + __expf(-x)); }
__device__ __forceinline__ float softplusf(float x) { return fmaxf(x, 0.f) + log1pf(expf(-fabsf(x))); }

constexpr int SMEM_BYTES = 36864 + 512;

__device__ __forceinline__ void convT_job(const Ctx& X, const float* __restrict__ src, int ld, int c0, int ncols, int K, u16* __restrict__ dst,
                          int ldd, float* sm, int bid, int nb) {
    const int tilesN = ncols / 64, tilesK = K / 64;
    const int tid = X.tid;
    for (int t = bid; t < tilesN * tilesK; t += nb) {
        const int tk = t / tilesN, tn = t % tilesN;
        __syncthreads();
        for (int e = tid; e < 4096; e += 256) {
            int r = e >> 6, c = e & 63;
            sm[r * 65 + c] = src[(size_t)(tk * 64 + r) * ld + c0 + tn * 64 + c];
        }
        __syncthreads();
        for (int e = tid; e < 4096; e += 256) {
            int n = e >> 6, k = e & 63;
            dst[(size_t)(tn * 64 + n) * ldd + tk * 64 + k] = f2bf(sm[k * 65 + n]);
        }
    }
}

__device__ __forceinline__ void phase_prologue(const Ctx& X, const Params& p, char* smem) {
    const int bid = X.bid, nb = X.nb, tid = X.tid;
    float* sm = (float*)smem;
    char* ws = p.ws;
    for (int L = 0; L < 2; ++L) {
        char* wl = ws + OFF_W + L * W_LAYER;
        const float* win = p.w_in + (size_t)L * 1024 * IN_DIM;
        convT_job(X, win, IN_DIM, 0, 1280, 1024, (u16*)(wl + W_IN), 1024, sm, bid, nb);
        convT_job(X, win, IN_DIM, 1288, 5120, 1024, (u16*)(wl + W_IN) + (size_t)1280 * 1024, 1024, sm, bid, nb);
        convT_job(X, win, IN_DIM, 6408, 4096, 1024, (u16*)(wl + W_G), 1024, sm, bid, nb);
        for (int i = 0; i < 4; ++i)
            convT_job(X, p.w_branch + ((size_t)L * 4 + i) * 512 * 1024, 1024, 0, 1024, 512,
                      (u16*)(wl + W_B) + (size_t)i * 1024 * 512, 512, sm, bid, nb);
        convT_job(X, p.w_out + (size_t)L * 1024 * 1024, 1024, 0, 1024, 1024, (u16*)(wl + W_O), 1024, sm, bid, nb);
        convT_job(X, p.w_xq + (size_t)L * 1024 * 1024, 1024, 0, 1024, 1024, (u16*)(wl + W_XQ), 1024, sm, bid, nb);
        convT_job(X, p.w_xkv + (size_t)L * 1024 * 2048, 2048, 0, 2048, 1024, (u16*)(wl + W_XKV), 1024, sm, bid, nb);
        convT_job(X, p.w_xo + (size_t)L * 1024 * 1024, 1024, 0, 1024, 1024, (u16*)(wl + W_XO), 1024, sm, bid, nb);
        convT_job(X, p.w_pq + (size_t)L * 1024 * 2048, 2048, 0, 2048, 1024, (u16*)(wl + W_PQ), 1024, sm, bid, nb);
        float* wdt = (float*)(ws + OFF_WDT) + L * 8 * 1024;
        for (int e = bid * 256 + tid; e < 8 * 1024; e += nb * 256) {
            int j = e >> 10, k = e & 1023;
            wdt[e] = win[(size_t)k * IN_DIM + 1280 + j];
        }
    }
    float* rope = (float*)(ws + OFF_ROPE);
    for (int e = bid * 256 + tid; e < 2048 * 32; e += nb * 256) {
        int pos = e >> 5, i = e & 31;
        float inv = powf(10000.f, -(float)i / 32.f);
        float ang = (float)pos * inv;
        rope[e * 2] = cosf(ang);
        rope[e * 2 + 1] = sinf(ang);
    }
    {
        u16* kd = (u16*)(ws + OFF_KEYS);
        for (int e = bid * 256 + tid; e < 2 * 8 * 2 * 128 * 128; e += nb * 256) kd[e] = f2bf(p.sub_keys[e]);
    }
    {
        const float4* xs = (const float4*)p.x;
        float4* hd = (float4*)(ws + OFF_H);
        for (size_t e = (size_t)bid * 256 + tid; e < (size_t)T_ * 256; e += (size_t)nb * 256) hd[e] = xs[e];
        u16* mb = (u16*)(ws + OFF_MEMB);
        for (int e = bid * 256 + tid; e < 2048 * 1024; e += nb * 256) mb[e] = f2bf(p.mem[e]);
    }
}

__device__ __forceinline__ void phase_norm(const Ctx& X, const Params& p, const float* __restrict__ gain, const float* __restrict__ wdt) {
    const int lane = X.tid & 63, wid = X.tid >> 6;
    const float* h = (const float*)(p.ws + OFF_H);
    u16* hn = (u16*)(p.ws + OFF_HN);
    float* dt = (float*)(p.ws + OFF_DT);
    for (int t = X.bid * 4 + wid; t < T_; t += X.nb * 4) {
        const float4* hr = (const float4*)(h + (size_t)t * 1024);
        float4 v[4];
        float ss = 0.f;
#pragma unroll
        for (int i = 0; i < 4; ++i) {
            v[i] = hr[lane + i * 64];
            ss += v[i].x * v[i].x + v[i].y * v[i].y + v[i].z * v[i].z + v[i].w * v[i].w;
        }
        ss = wsum(ss);
        const float r = rsqrtf(ss * (1.f / 1024.f) + 1e-6f);
#pragma unroll
        for (int i = 0; i < 4; ++i) {
            float4 g = ((const float4*)gain)[lane + i * 64];
            v[i].x *= r * g.x; v[i].y *= r * g.y; v[i].z *= r * g.z; v[i].w *= r * g.w;
            ushort4 o;
            o.x = f2bf(v[i].x); o.y = f2bf(v[i].y); o.z = f2bf(v[i].z); o.w = f2bf(v[i].w);
            ((ushort4*)(hn + (size_t)t * 1024))[lane + i * 64] = o;
        }
        if (wdt) {
#pragma unroll
            for (int j = 0; j < 8; ++j) {
                float a = 0.f;
#pragma unroll
                for (int i = 0; i < 4; ++i) {
                    float4 w = ((const float4*)(wdt + j * 1024))[lane + i * 64];
                    a += v[i].x * w.x + v[i].y * w.y + v[i].z * w.z + v[i].w * w.w;
                }
                a = wsum(a);
                if (lane == 0) dt[t * 8 + j] = a;
            }
        }
    }
}

__device__ __forceinline__ void phase_final(const Ctx& X, const Params& p) {
    const int lane = X.tid & 63, wid = X.tid >> 6;
    const float* h = (const float*)(p.ws + OFF_H);
    for (int t = X.bid * 4 + wid; t < T_; t += X.nb * 4) {
        const float4* hr = (const float4*)(h + (size_t)t * 1024);
        float4 v[4];
        float ss = 0.f;
#pragma unroll
        for (int i = 0; i < 4; ++i) {
            v[i] = hr[lane + i * 64];
            ss += v[i].x * v[i].x + v[i].y * v[i].y + v[i].z * v[i].z + v[i].w * v[i].w;
        }
        ss = wsum(ss);
        const float r = rsqrtf(ss * (1.f / 1024.f) + 1e-6f);
#pragma unroll
        for (int i = 0; i < 4; ++i) {
            float4 g = ((const float4*)p.final_norm)[lane + i * 64];
            float4 o;
            o.x = v[i].x * r * g.x; o.y = v[i].y * r * g.y; o.z = v[i].z * r * g.z; o.w = v[i].w * r * g.w;
            ((float4*)(p.out + (size_t)t * 1024))[lane + i * 64] = o;
        }
    }
}

constexpr int LDT = 72;
template <int BM, int BN>
__device__ __forceinline__ void gemm_core(const Ctx& X, const u16* __restrict__ Ag, int lda, const u16* __restrict__ Bg, int ldb,
                                          int K, f32x4 (&acc)[BM / 32][BN / 32], u16* sA, u16* sB) {
    constexpr int NA = BM / 32, NB = BN / 32;
    const int tid = X.tid, lane = tid & 63, wid = tid >> 6;
    const int wr = wid >> 1, wc = wid & 1, fr = lane & 15, fq = lane >> 4;
    u32x4 ra[NA], rb[NB];
#pragma unroll
    for (int i = 0; i < NA; ++i) {
        int ch = tid + i * 256;
        ra[i] = *(const u32x4*)(Ag + (size_t)(ch >> 3) * lda + (ch & 7) * 8);
    }
#pragma unroll
    for (int i = 0; i < NB; ++i) {
        int ch = tid + i * 256;
        rb[i] = *(const u32x4*)(Bg + (size_t)(ch >> 3) * ldb + (ch & 7) * 8);
    }
    for (int k0 = 0; k0 < K; k0 += 64) {
        __syncthreads();
#pragma unroll
        for (int i = 0; i < NA; ++i) {
            int ch = tid + i * 256;
            *(u32x4*)(sA + (ch >> 3) * LDT + (ch & 7) * 8) = ra[i];
        }
#pragma unroll
        for (int i = 0; i < NB; ++i) {
            int ch = tid + i * 256;
            *(u32x4*)(sB + (ch >> 3) * LDT + (ch & 7) * 8) = rb[i];
        }
        __syncthreads();
        if (k0 + 64 < K) {
#pragma unroll
            for (int i = 0; i < NA; ++i) {
                int ch = tid + i * 256;
                ra[i] = *(const u32x4*)(Ag + (size_t)(ch >> 3) * lda + k0 + 64 + (ch & 7) * 8);
            }
#pragma unroll
            for (int i = 0; i < NB; ++i) {
                int ch = tid + i * 256;
                rb[i] = *(const u32x4*)(Bg + (size_t)(ch >> 3) * ldb + k0 + 64 + (ch & 7) * 8);
            }
        }
#pragma unroll
        for (int ks = 0; ks < 2; ++ks) {
            bf16x8 af[NA], bfr[NB];
#pragma unroll
            for (int m = 0; m < NA; ++m)
                af[m] = *(const bf16x8*)(sA + (wr * (BM / 2) + m * 16 + fr) * LDT + ks * 32 + fq * 8);
#pragma unroll
            for (int n = 0; n < NB; ++n)
                bfr[n] = *(const bf16x8*)(sB + (wc * (BN / 2) + n * 16 + fr) * LDT + ks * 32 + fq * 8);
#pragma unroll
            for (int m = 0; m < NA; ++m)
#pragma unroll
                for (int n = 0; n < NB; ++n)
                    acc[m][n] = __builtin_amdgcn_mfma_f32_16x16x32_bf16(af[m], bfr[n], acc[m][n], 0, 0, 0);
        }
    }
}

enum { EPI_PROJ = 0, EPI_BF16 = 1, EPI_RESID = 2 };

template <int EPI>
__device__ __forceinline__ void phase_gemm(const Ctx& X, const Params& p, const u16* __restrict__ A, int lda, const u16* __restrict__ Bt, int M,
                           int N, int K, void* Cout, int ldc, char* smem) {
    u16* sA = (u16*)smem;
    u16* sB = sA + 128 * LDT;
    const int nM = M / 128, nN = N / 128;
    const int tid = X.tid, lane = tid & 63, wid = tid >> 6;
    const int wr = wid >> 1, wc = wid & 1, fr = lane & 15, fq = lane >> 4;
    const float* rope = (const float*)(p.ws + OFF_ROPE);
    for (int tile = X.bid; tile < nM * nN; tile += X.nb) {
        const int tm = tile % nM, tn = tile / nM;
        f32x4 acc[4][4];
#pragma unroll
        for (int m = 0; m < 4; ++m)
#pragma unroll
            for (int n = 0; n < 4; ++n) acc[m][n] = f32x4{0.f, 0.f, 0.f, 0.f};
        gemm_core<128, 128>(X, A + (size_t)tm * 128 * lda, lda, Bt + (size_t)tn * 128 * K, K, K, acc, sA, sB);
        const int row0 = tm * 128 + wr * 64, col0 = tn * 128 + wc * 64;
        if (EPI == EPI_PROJ) {
            u16* C = (u16*)Cout;
            int mode = 0;
            if ((col0 >= C_RQ && col0 < C_RK) || (col0 >= C_MQ && col0 < C_MV) || (col0 >= C_DQ && col0 < C_DV)) mode = 1;
            if (col0 >= C_RK && col0 < C_RV) mode = 2;
            if (mode == 0) {
#pragma unroll
                for (int m = 0; m < 4; ++m)
#pragma unroll
                    for (int n = 0; n < 4; ++n)
#pragma unroll
                        for (int j = 0; j < 4; ++j)
                            C[(size_t)(row0 + m * 16 + fq * 4 + j) * ldc + col0 + n * 16 + fr] = f2bf(acc[m][n][j]);
            } else {
                const float sc = (mode == 2) ? 0.125f : 1.f;
#pragma unroll
                for (int m = 0; m < 4; ++m)
#pragma unroll
                    for (int j = 0; j < 4; ++j) {
                        const int row = row0 + m * 16 + fq * 4 + j;
                        const int pos = row & (S_ - 1);
#pragma unroll
                        for (int n = 0; n < 2; ++n) {
                            const int d = n * 16 + fr;
                            const float2 cs = *(const float2*)(rope + ((size_t)pos * 32 + d) * 2);
                            const float t1 = acc[m][n][j], t2 = acc[m][n + 2][j];
                            C[(size_t)row * ldc + col0 + d] = f2bf((t1 * cs.x - t2 * cs.y) * sc);
                            C[(size_t)row * ldc + col0 + d + 32] = f2bf((t2 * cs.x + t1 * cs.y) * sc);
                        }
                    }
            }
        } else if (EPI == EPI_BF16) {
            u16* C = (u16*)Cout;
#pragma unroll
            for (int m = 0; m < 4; ++m)
#pragma unroll
                for (int n = 0; n < 4; ++n)
#pragma unroll
                    for (int j = 0; j < 4; ++j)
                        C[(size_t)(row0 + m * 16 + fq * 4 + j) * ldc + col0 + n * 16 + fr] = f2bf(acc[m][n][j]);
        } else {
            float* C = (float*)Cout;
#pragma unroll
            for (int m = 0; m < 4; ++m)
#pragma unroll
                for (int n = 0; n < 4; ++n)
#pragma unroll
                    for (int j = 0; j < 4; ++j) {
                        float* q = &C[(size_t)(row0 + m * 16 + fq * 4 + j) * ldc + col0 + n * 16 + fr];
                        *q = *q + acc[m][n][j];
                    }
        }
    }
}

__device__ __forceinline__ void phase_merge(const Ctx& X, const Params& p, int L, char* smem) {
    u16* sA = (u16*)smem;
    u16* sB = sA + 128 * LDT;
    const char* wl = p.ws + OFF_W + L * W_LAYER;
    const u16* hn = (const u16*)(p.ws + OFF_HN);
    const u16* ys = (const u16*)(p.ws + OFF_YS);
    u16* merged = (u16*)(p.ws + OFF_MERGED);
    const int nM = T_ / 128, nN = 1024 / 64;
    const int tid = X.tid, lane = tid & 63, wid = tid >> 6;
    const int wr = wid >> 1, wc = wid & 1, fr = lane & 15, fq = lane >> 4;
    for (int tile = X.bid; tile < nM * nN; tile += X.nb) {
        const int tm = tile % nM, tn = tile / nM;
        f32x4 accm[4][2];
#pragma unroll
        for (int m = 0; m < 4; ++m)
#pragma unroll
            for (int n = 0; n < 2; ++n) accm[m][n] = f32x4{0.f, 0.f, 0.f, 0.f};
        for (int i = 0; i < 4; ++i) {
            f32x4 accg[4][2], accb[4][2];
#pragma unroll
            for (int m = 0; m < 4; ++m)
#pragma unroll
                for (int n = 0; n < 2; ++n) {
                    accg[m][n] = f32x4{0.f, 0.f, 0.f, 0.f};
                    accb[m][n] = f32x4{0.f, 0.f, 0.f, 0.f};
                }
            gemm_core<128, 64>(X, hn + (size_t)tm * 128 * 1024, 1024,
                               (const u16*)(wl + W_G) + (size_t)(i * 1024 + tn * 64) * 1024, 1024, 1024, accg, sA, sB);
            gemm_core<128, 64>(X, ys + ((size_t)i * T_ + (size_t)tm * 128) * 512, 512,
                               (const u16*)(wl + W_B) + ((size_t)i * 1024 + tn * 64) * 512, 512, 512, accb, sA, sB);
#pragma unroll
            for (int m = 0; m < 4; ++m)
#pragma unroll
                for (int n = 0; n < 2; ++n)
#pragma unroll
                    for (int j = 0; j < 4; ++j) accm[m][n][j] += sigmf(accg[m][n][j]) * accb[m][n][j];
        }
        const int row0 = tm * 128 + wr * 64, col0 = tn * 64 + wc * 32;
#pragma unroll
        for (int m = 0; m < 4; ++m)
#pragma unroll
            for (int n = 0; n < 2; ++n)
#pragma unroll
                for (int j = 0; j < 4; ++j)
                    merged[(size_t)(row0 + m * 16 + fq * 4 + j) * 1024 + col0 + n * 16 + fr] = f2bf(accm[m][n][j]);
    }
}

__device__ __forceinline__ void phase_kmean(const Ctx& X, const Params& p) {
    const u16* proj = (const u16*)(p.ws + OFF_PROJ);
    float* km = (float*)(p.ws + OFF_KMEAN);
    for (int e = X.bid * 256 + X.tid; e < 8 * 8 * 8 * 64; e += X.nb * 256) {
        const int d = e & 63, n = (e >> 6) & 7, h = (e >> 9) & 7, b = e >> 12;
        float a = 0.f;
        const u16* kp = proj + ((size_t)b * S_ + n * 256) * NPROJ + C_MK + h * 64 + d;
        for (int j = 0; j < 256; ++j) a += bf2f(kp[(size_t)j * NPROJ]);
        km[e] = a * (1.f / 256.f);
    }
}

__device__ __forceinline__ void attn_tile64(const float (&q)[64], const u16* __restrict__ kb, const u16* __restrict__ vb,
                                            int pos, float scale, float& m, float& l, float& o, int lane) {
    float s = -1e30f;
    if (pos >= 0) {
        const uint4* kr = (const uint4*)(kb + (size_t)pos * NPROJ);
        float a = 0.f;
#pragma unroll
        for (int c = 0; c < 8; ++c) {
            uint4 w = kr[c];
            a += q[c * 8 + 0] * __uint_as_float(w.x << 16) + q[c * 8 + 1] * __uint_as_float(w.x & 0xffff0000u);
            a += q[c * 8 + 2] * __uint_as_float(w.y << 16) + q[c * 8 + 3] * __uint_as_float(w.y & 0xffff0000u);
            a += q[c * 8 + 4] * __uint_as_float(w.z << 16) + q[c * 8 + 5] * __uint_as_float(w.z & 0xffff0000u);
            a += q[c * 8 + 6] * __uint_as_float(w.w << 16) + q[c * 8 + 7] * __uint_as_float(w.w & 0xffff0000u);
        }
        s = a * scale;
    }
    const float tmax = wmax(s);
    if (tmax < -1e29f) return;
    const float mn = fmaxf(m, tmax);
    const float alpha = __expf(m - mn);
    const float pr = (pos >= 0) ? __expf(s - mn) : 0.f;
    l = l * alpha + wsum(pr);
    o *= alpha;
#pragma unroll 8
    for (int j = 0; j < 64; ++j) {
        const int pj = __shfl(pos, j);
        const float pp = __shfl(pr, j);
        if (pj >= 0) o += pp * bf2f(vb[(size_t)pj * NPROJ + lane]);
    }
    m = mn;
}

__device__ __forceinline__ void load_q64(float (&q)[64], const u16* qp) {
#pragma unroll
    for (int c = 0; c < 8; ++c) {
        uint4 w = ((const uint4*)qp)[c];
        q[c * 8 + 0] = __uint_as_float(w.x << 16); q[c * 8 + 1] = __uint_as_float(w.x & 0xffff0000u);
        q[c * 8 + 2] = __uint_as_float(w.y << 16); q[c * 8 + 3] = __uint_as_float(w.y & 0xffff0000u);
        q[c * 8 + 4] = __uint_as_float(w.z << 16); q[c * 8 + 5] = __uint_as_float(w.z & 0xffff0000u);
        q[c * 8 + 6] = __uint_as_float(w.w << 16); q[c * 8 + 7] = __uint_as_float(w.w & 0xffff0000u);
    }
}

__device__ __forceinline__ void moba_query(const Params& p, int b, int h, int i, int lane) {
    const u16* proj = (const u16*)(p.ws + OFF_PROJ);
    const u16* base = proj + (size_t)b * S_ * NPROJ;
    float q[64];
    load_q64(q, base + (size_t)i * NPROJ + C_MQ + h * 64);
    const int nq = i >> 8;
    int sel0 = -1, sel1 = -1, sel2 = -1;
    {
        const float* km = (const float*)(p.ws + OFF_KMEAN) + ((size_t)(b * 8 + h) * 8) * 64;
        float g[8];
#pragma unroll
        for (int n = 0; n < 8; ++n) {
            float a = 0.f;
#pragma unroll
            for (int d = 0; d < 64; ++d) a += q[d] * km[n * 64 + d];
            g[n] = (n < nq) ? a : -INFINITY;
        }
#pragma unroll
        for (int r = 0; r < 3; ++r) {
            int bi = -1;
            float bv = -INFINITY;
#pragma unroll
            for (int n = 0; n < 8; ++n)
                if (g[n] > bv) { bv = g[n]; bi = n; }
            if (bi >= 0) {
#pragma unroll
                for (int n = 0; n < 8; ++n)
                    if (n == bi) g[n] = -INFINITY;
            }
            if (r == 0) sel0 = bi; else if (r == 1) sel1 = bi; else sel2 = bi;
        }
    }
    const u16* kb = base + C_MK + h * 64;
    const u16* vb = base + C_MV + h * 64;
    float m = -1e30f, l = 0.f, o = 0.f;
    for (int j0 = nq * 256; j0 <= i; j0 += 64) {
        const int pos = (j0 + lane <= i) ? (j0 + lane) : -1;
        attn_tile64(q, kb, vb, pos, 0.125f, m, l, o, lane);
    }
#pragma unroll
    for (int r = 0; r < 3; ++r) {
        const int sb = (r == 0) ? sel0 : (r == 1) ? sel1 : sel2;
        if (sb >= 0) {
            for (int j0 = sb * 256; j0 < sb * 256 + 256; j0 += 64) attn_tile64(q, kb, vb, j0 + lane, 0.125f, m, l, o, lane);
        }
    }
    u16* ys = (u16*)(p.ws + OFF_YS) + (size_t)2 * T_ * 512;
    ys[((size_t)b * S_ + i) * 512 + h * 64 + lane] = f2bf(o / l);
}

__device__ __forceinline__ void dil_query(const Params& p, int b, int h, int i, int lane) {
    const u16* proj = (const u16*)(p.ws + OFF_PROJ);
    const u16* base = proj + (size_t)b * S_ * NPROJ;
    float q[64];
    load_q64(q, base + (size_t)i * NPROJ + C_DQ + h * 64);
    const u16* kb = base + C_DK + h * 64;
    const u16* vb = base + C_DV + h * 64;
    float m = -1e30f, l = 0.f, o = 0.f;
#pragma unroll
    for (int g = 0; g < 3; ++g) {
        const int dil = (g == 0) ? 1 : (g == 1) ? 4 : 16;
        for (int k0 = 0; k0 <= 128; k0 += 64) {
            const int k = k0 + lane;
            int pos = (k <= 128) ? (i - k * dil) : -1;
            if (pos < 0) pos = -1;
            attn_tile64(q, kb, vb, pos, 0.125f, m, l, o, lane);
        }
    }
    u16* ys = (u16*)(p.ws + OFF_YS) + (size_t)3 * T_ * 512;
    ys[((size_t)b * S_ + i) * 512 + h * 64 + lane] = f2bf(o / l);
}


using s16x4 = __attribute__((ext_vector_type(4))) short;
typedef __attribute__((address_space(3))) s16x4 lds_s16x4;
typedef __bf16 bf16v2 __attribute__((ext_vector_type(2)));
typedef float f32v2 __attribute__((ext_vector_type(2)));
__device__ __forceinline__ unsigned pack2(float a, float b) {
    f32v2 v = {a, b};
    bf16v2 r = __builtin_convertvector(v, bf16v2);
    return __builtin_bit_cast(unsigned, r);
}
__device__ __forceinline__ bf16x8 tr_pair(const u16* sV, int row_lo, int row_hi, int col, int pitch, int li) {
    const u16* a0 = sV + (row_lo + (li >> 2)) * pitch + col + (li & 3) * 4;
    const u16* a1 = sV + (row_hi + (li >> 2)) * pitch + col + (li & 3) * 4;
    s16x4 lo = __builtin_amdgcn_ds_read_tr16_b64_v4i16((lds_s16x4*)a0);
    s16x4 hi = __builtin_amdgcn_ds_read_tr16_b64_v4i16((lds_s16x4*)a1);
    bf16x8 r;
    r[0] = lo[0]; r[1] = lo[1]; r[2] = lo[2]; r[3] = lo[3];
    r[4] = hi[0]; r[5] = hi[1]; r[6] = hi[2]; r[7] = hi[3];
    return r;
}
template <int NB>
struct FlashStateT {
    float m, l;
    f32x4 o[NB];
};
typedef FlashStateT<4> FlashState;
template <int NB>
__device__ __forceinline__ void flash_update(f32x4 (&st)[4], FlashStateT<NB>& fs, const u16* sV, int pitch, int li, int g) {
    float mx = -1e30f;
#pragma unroll
    for (int kb = 0; kb < 4; ++kb)
#pragma unroll
        for (int j = 0; j < 4; ++j) mx = fmaxf(mx, st[kb][j]);
    mx = fmaxf(mx, __shfl_xor(mx, 16));
    mx = fmaxf(mx, __shfl_xor(mx, 32));
    const float mnew = fmaxf(fs.m, mx);
    const float alpha = __expf(fs.m - mnew);
    float rs = 0.f;
#pragma unroll
    for (int kb = 0; kb < 4; ++kb)
#pragma unroll
        for (int j = 0; j < 4; ++j) {
            const float pv = (st[kb][j] > -1e29f) ? __expf(st[kb][j] - mnew) : 0.f;
            st[kb][j] = pv;
            rs += pv;
        }
    rs += __shfl_xor(rs, 16);
    rs += __shfl_xor(rs, 32);
    fs.l = fs.l * alpha + rs;
    fs.m = mnew;
#pragma unroll
    for (int j = 0; j < 4; ++j) {
        const float aj = __shfl(alpha, 4 * g + j);
#pragma unroll
        for (int nb = 0; nb < NB; ++nb) fs.o[nb][j] *= aj;
    }
#pragma unroll
    for (int c = 0; c < 2; ++c) {
        union { bf16x8 v; unsigned u[4]; } pa;
        pa.u[0] = pack2(st[2 * c][0], st[2 * c][1]);
        pa.u[1] = pack2(st[2 * c][2], st[2 * c][3]);
        pa.u[2] = pack2(st[2 * c + 1][0], st[2 * c + 1][1]);
        pa.u[3] = pack2(st[2 * c + 1][2], st[2 * c + 1][3]);
#pragma unroll
        for (int nb = 0; nb < NB; ++nb) {
            const bf16x8 bv = tr_pair(sV, 2 * c * 16 + 4 * g, (2 * c + 1) * 16 + 4 * g, nb * 16, pitch, li);
            fs.o[nb] = __builtin_amdgcn_mfma_f32_16x16x32_bf16(pa.v, bv, fs.o[nb], 0, 0, 0);
        }
    }
}

__device__ __forceinline__ void phase_moba(const Ctx& X, const Params& p, char* smem) {
    const int tid = X.tid, lane = tid & 63, w = tid >> 6, li = lane & 15, g = lane >> 4;
    u16* sK = (u16*)smem;
    u16* sV = sK + 64 * 72;
    float* sKm = (float*)(smem + 18432);
    int* sMask = (int*)(smem + 20480);
    const u16* proj = (const u16*)(p.ws + OFF_PROJ);
    const float* km = (const float*)(p.ws + OFF_KMEAN);
    u16* ys = (u16*)(p.ws + OFF_YS) + (size_t)2 * T_ * 512;
    for (int it = X.bid; it < 2048; it += X.nb) {
        const int qt = 31 - (it >> 6);
        const int bh = it & 63, b = bh >> 3, h = bh & 7;
        const int q0 = qt * 64, nq = q0 >> 8;
        const u16* base = proj + (size_t)b * S_ * NPROJ;
        __syncthreads();
        for (int e = tid; e < 512; e += 256) sKm[e] = km[(size_t)(b * 8 + h) * 512 + e];
        if (tid == 0) *sMask = 0;
        const int qrow = q0 + 16 * w + li;
        bf16x8 qf[2];
#pragma unroll
        for (int ks = 0; ks < 2; ++ks)
            qf[ks] = *(const bf16x8*)(base + (size_t)qrow * NPROJ + C_MQ + h * 64 + ks * 32 + g * 8);
        __syncthreads();
        int selmask = 0;
        if (nq > 0) {
            float gt[8];
#pragma unroll
            for (int n = 0; n < 8; ++n) {
                float a = 0.f;
#pragma unroll
                for (int ks = 0; ks < 2; ++ks)
#pragma unroll
                    for (int j = 0; j < 8; ++j) a += bf2f((u16)qf[ks][j]) * sKm[n * 64 + ks * 32 + g * 8 + j];
                a += __shfl_xor(a, 16);
                a += __shfl_xor(a, 32);
                gt[n] = (n < nq) ? a : -INFINITY;
            }
#pragma unroll
            for (int r = 0; r < 3; ++r) {
                int bi = -1;
                float bv = -INFINITY;
#pragma unroll
                for (int n = 0; n < 8; ++n)
                    if (gt[n] > bv) { bv = gt[n]; bi = n; }
                if (bi >= 0) {
                    selmask |= 1 << bi;
#pragma unroll
                    for (int n = 0; n < 8; ++n)
                        if (n == bi) gt[n] = -INFINITY;
                }
            }
            if (selmask) atomicOr(sMask, selmask);
        }
        __syncthreads();
        const int bmask = *sMask;
        FlashState fs;
        fs.m = -1e30f; fs.l = 0.f;
#pragma unroll
        for (int nb = 0; nb < 4; ++nb) fs.o[nb] = f32x4{0.f, 0.f, 0.f, 0.f};
        const int nPast = nq * 4, nOwn = ((q0 - nq * 256) >> 6) + 1;
        for (int t = 0; t < nPast + nOwn; ++t) {
            int k0, nblk = 0;
            const bool past = t < nPast;
            if (past) {
                nblk = t >> 2;
                if (!((bmask >> nblk) & 1)) continue;
                k0 = nblk * 256 + (t & 3) * 64;
            } else {
                k0 = nq * 256 + (t - nPast) * 64;
            }
            __syncthreads();
#pragma unroll
            for (int i = 0; i < 2; ++i) {
                const int ch = tid + i * 256, r = ch >> 3, c8 = (ch & 7) * 8;
                *(u32x4*)(sK + r * 72 + c8) = *(const u32x4*)(base + (size_t)(k0 + r) * NPROJ + C_MK + h * 64 + c8);
                *(u32x4*)(sV + r * 72 + c8) = *(const u32x4*)(base + (size_t)(k0 + r) * NPROJ + C_MV + h * 64 + c8);
            }
            __syncthreads();
            f32x4 st[4];
#pragma unroll
            for (int kb = 0; kb < 4; ++kb) {
                st[kb] = f32x4{0.f, 0.f, 0.f, 0.f};
#pragma unroll
                for (int ks = 0; ks < 2; ++ks) {
                    const bf16x8 a = *(const bf16x8*)(sK + (kb * 16 + li) * 72 + ks * 32 + g * 8);
                    st[kb] = __builtin_amdgcn_mfma_f32_16x16x32_bf16(a, qf[ks], st[kb], 0, 0, 0);
                }
            }
            const bool lane_ok = past ? (((selmask >> nblk) & 1) != 0) : true;
#pragma unroll
            for (int kb = 0; kb < 4; ++kb)
#pragma unroll
                for (int j = 0; j < 4; ++j) {
                    const int key = k0 + kb * 16 + 4 * g + j;
                    const bool valid = lane_ok && (past || key <= qrow);
                    st[kb][j] = valid ? st[kb][j] * 0.125f : -1e30f;
                }
            flash_update<4>(st, fs, sV, 72, li, g);
        }
#pragma unroll
        for (int j = 0; j < 4; ++j) {
            const float inv = 1.f / __shfl(fs.l, 4 * g + j);
            const int row = q0 + 16 * w + 4 * g + j;
#pragma unroll
            for (int nb = 0; nb < 4; ++nb)
                ys[((size_t)b * S_ + row) * 512 + h * 64 + nb * 16 + li] = f2bf(fs.o[nb][j] * inv);
        }
    }
}

__device__ __forceinline__ void phase_dil(const Ctx& X, const Params& p, char* smem) {
    const int tid = X.tid, lane = tid & 63, w = tid >> 6, li = lane & 15, g = lane >> 4;
    u16* sV = (u16*)smem + w * (64 * 72);
    const u16* proj = (const u16*)(p.ws + OFF_PROJ);
    u16* ys = (u16*)(p.ws + OFF_YS) + (size_t)3 * T_ * 512;
    for (int it = X.bid; it < 2048; it += X.nb) {
        const int wi = it * 4 + w;
        const int u0 = (wi & 7) * 16, r16 = (wi >> 3) & 15, h = (wi >> 7) & 7, b = wi >> 10;
        const u16* base = proj + (size_t)b * S_ * NPROJ;
        const int iq = r16 + 16 * (u0 + li);
        bf16x8 qf[2];
#pragma unroll
        for (int ks = 0; ks < 2; ++ks)
            qf[ks] = *(const bf16x8*)(base + (size_t)iq * NPROJ + C_DQ + h * 64 + ks * 32 + g * 8);
        FlashState fs;
        fs.m = -1e30f; fs.l = 0.f;
#pragma unroll
        for (int nb = 0; nb < 4; ++nb) fs.o[nb] = f32x4{0.f, 0.f, 0.f, 0.f};
        for (int t = 0; t < 12; ++t) {
            int dl, tt;
            if (t < 3) { dl = 16; tt = t; } else if (t < 6) { dl = 4; tt = t - 3; } else { dl = 1; tt = t - 6; }
            const int res = r16 & (dl - 1), a = r16 / dl, sq = 16 / dl;
            const int uq = a + sq * (u0 + li);
            const int uq0 = a + sq * u0;
            const int kt0 = uq0 - 128 + 64 * tt;
            const bool active = (kt0 + 63 >= 0);
            __syncthreads();
            if (active) {
#pragma unroll
                for (int i = 0; i < 8; ++i) {
                    const int ch = lane + i * 64, r = ch >> 3, c8 = (ch & 7) * 8;
                    int uk = kt0 + r;
                    uk = uk < 0 ? 0 : uk;
                    int tok = res + dl * uk;
                    tok = tok > S_ - 1 ? S_ - 1 : tok;
                    *(u32x4*)(sV + r * 72 + c8) = *(const u32x4*)(base + (size_t)tok * NPROJ + C_DV + h * 64 + c8);
                }
            }
            __syncthreads();
            if (active) {
                f32x4 st[4];
#pragma unroll
                for (int kb = 0; kb < 4; ++kb) {
                    int uk = kt0 + kb * 16 + li;
                    uk = uk < 0 ? 0 : uk;
                    int tok = res + dl * uk;
                    tok = tok > S_ - 1 ? S_ - 1 : tok;
                    st[kb] = f32x4{0.f, 0.f, 0.f, 0.f};
#pragma unroll
                    for (int ks = 0; ks < 2; ++ks) {
                        const bf16x8 ka = *(const bf16x8*)(base + (size_t)tok * NPROJ + C_DK + h * 64 + ks * 32 + g * 8);
                        st[kb] = __builtin_amdgcn_mfma_f32_16x16x32_bf16(ka, qf[ks], st[kb], 0, 0, 0);
                    }
                }
#pragma unroll
                for (int kb = 0; kb < 4; ++kb)
#pragma unroll
                    for (int j = 0; j < 4; ++j) {
                        const int uk = kt0 + kb * 16 + 4 * g + j;
                        const int dist = uq - uk;
                        const bool valid = (uk >= 0) && (dist >= 0) && (dist <= 128);
                        st[kb][j] = valid ? st[kb][j] * 0.125f : -1e30f;
                    }
                flash_update<4>(st, fs, sV, 72, li, g);
            }
        }
#pragma unroll
        for (int j = 0; j < 4; ++j) {
            const float inv = 1.f / __shfl(fs.l, 4 * g + j);
            const int tok = r16 + 16 * (u0 + 4 * g + j);
#pragma unroll
            for (int nb = 0; nb < 4; ++nb)
                ys[((size_t)b * S_ + tok) * 512 + h * 64 + nb * 16 + li] = f2bf(fs.o[nb][j] * inv);
        }
    }
}


__device__ __forceinline__ void phase_premix(const Ctx& X, const Params& p, int L) {
    const u16* proj = (const u16*)(p.ws + OFF_PROJ);
    u16* cv = (u16*)(p.ws + OFF_CONV);
    const float* cw = p.conv_w + (size_t)L * 4 * 768;
    const float* cb = p.conv_b + (size_t)L * 768;
    for (int e = X.bid * 256 + X.tid; e < T_ * 96; e += X.nb * 256) {
        const int t = e / 96, c8 = (e % 96) * 8, s = t & (S_ - 1);
        float acc[8];
#pragma unroll
        for (int i = 0; i < 8; ++i) acc[i] = cb[c8 + i];
#pragma unroll
        for (int k = 0; k < 4; ++k) {
            if (s - 3 + k >= 0) {
                const u32x4 v = *(const u32x4*)(proj + (size_t)(t - 3 + k) * NPROJ + C_XBC + c8);
#pragma unroll
                for (int i = 0; i < 4; ++i) {
                    acc[2 * i] += cw[k * 768 + c8 + 2 * i] * __uint_as_float(v[i] << 16);
                    acc[2 * i + 1] += cw[k * 768 + c8 + 2 * i + 1] * __uint_as_float(v[i] & 0xffff0000u);
                }
            }
        }
        u32x4 o;
#pragma unroll
        for (int i = 0; i < 4; ++i) o[i] = pack2(siluf(acc[2 * i]), siluf(acc[2 * i + 1]));
        *(u32x4*)(cv + (size_t)t * 768 + c8) = o;
    }
    const float* dtr = (const float*)(p.ws + OFF_DT);
    float* dtv = (float*)(p.ws + OFF_DTV);
    float* acv = (float*)(p.ws + OFF_ACUM);
    for (int e = X.bid * 256 + X.tid; e < 8 * 32 * 8; e += X.nb * 256) {
        const int h = e & 7, ch = e >> 3;
        const float bias = p.dt_bias[L * 8 + h], A = -expf(p.a_log[L * 8 + h]);
        float ac = 0.f;
        for (int i = 0; i < 64; ++i) {
            const int t = ch * 64 + i;
            const float dt = softplusf(dtr[t * 8 + h] + bias);
            ac += dt * A;
            dtv[t * 8 + h] = dt;
            acv[t * 8 + h] = ac;
        }
    }
}

template <bool SSD>
__device__ __forceinline__ void linattn_item(const Ctx& X, const Params& p, int L, int b, int h, char* smem) {
    const int tid = X.tid, lane = tid & 63, w = tid >> 6, li = lane & 15, g = lane >> 4;
    u16* sK = (u16*)smem;
    u16* sV = sK + 64 * 72;
    u16* sVd = sV + 64 * 72;
    u16* sSt = sVd + 64 * 72;
    float* sAc = (float*)(smem + 36864);
    const u16* proj = (const u16*)(p.ws + OFF_PROJ) + (size_t)b * S_ * NPROJ;
    const u16* cv = (const u16*)(p.ws + OFF_CONV) + (size_t)b * S_ * 768;
    const float* dtv = (const float*)(p.ws + OFF_DTV) + (size_t)b * S_ * 8;
    const float* acv = (const float*)(p.ws + OFF_ACUM) + (size_t)b * S_ * 8;
    const u16 *qsrc, *ksrc, *vsrc;
    int ld;
    if (SSD) { qsrc = cv + 640 + (h >> 2) * 64; ksrc = cv + 512 + (h >> 2) * 64; vsrc = cv + h * 64; ld = 768; }
    else { qsrc = proj + C_RQ + h * 64; ksrc = proj + C_RK + h * 64; vsrc = proj + C_RV + h * 64; ld = NPROJ; }
    const float lg = log2f(1.f - exp2f(-5.f - (float)h));
    float crs[4];
#pragma unroll
    for (int j = 0; j < 4; ++j) crs[j] = exp2f((float)(16 * w + 4 * g + j + 1) * lg);
    const float sdecR = exp2f(64.f * lg);
    const int r0 = tid >> 3, c8 = (tid & 7) * 8;
    const float vds0 = exp2f((float)(63 - r0) * lg), vds1 = exp2f((float)(31 - r0) * lg);
    f32x4 accs[4];
#pragma unroll
    for (int n = 0; n < 4; ++n) accs[n] = f32x4{0.f, 0.f, 0.f, 0.f};
    u32x4 rk[2], rv[2];
    bf16x8 qn[2];
#pragma unroll
    for (int i = 0; i < 2; ++i) {
        rk[i] = *(const u32x4*)(ksrc + (r0 + 32 * i) * ld + c8);
        rv[i] = *(const u32x4*)(vsrc + (r0 + 32 * i) * ld + c8);
    }
#pragma unroll
    for (int ks = 0; ks < 2; ++ks) qn[ks] = *(const bf16x8*)(qsrc + (16 * w + li) * ld + ks * 32 + g * 8);
    const float gainv0 = SSD ? 0.f : 0.f;
    (void)gainv0;
    for (int c = 0; c < 32; ++c) {
        const int t0 = c * 64;
        __syncthreads();
#pragma unroll
        for (int n = 0; n < 4; ++n)
#pragma unroll
            for (int j = 0; j < 4; ++j) sSt[(16 * w + 4 * g + j) * 72 + n * 16 + li] = f2bf(accs[n][j]);
        float aclast = 0.f;
        if (SSD) {
            aclast = acv[(t0 + 63) * 8 + h];
            if (tid < 64) sAc[tid] = acv[(t0 + tid) * 8 + h];
        }
#pragma unroll
        for (int i = 0; i < 2; ++i) {
            const int r = r0 + 32 * i;
            *(u32x4*)(sK + r * 72 + c8) = rk[i];
            float s1 = 1.f, s2;
            if (SSD) {
                s1 = dtv[(t0 + r) * 8 + h];
                s2 = s1 * __expf(aclast - acv[(t0 + r) * 8 + h]);
            } else {
                s2 = (i == 0) ? vds0 : vds1;
            }
            u32x4 o1, o2;
#pragma unroll
            for (int q = 0; q < 4; ++q) {
                const float lo = __uint_as_float(rv[i][q] << 16), hi = __uint_as_float(rv[i][q] & 0xffff0000u);
                o1[q] = SSD ? pack2(lo * s1, hi * s1) : rv[i][q];
                o2[q] = pack2(lo * s2, hi * s2);
            }
            *(u32x4*)(sV + r * 72 + c8) = o1;
            *(u32x4*)(sVd + r * 72 + c8) = o2;
        }
        __syncthreads();
        bf16x8 qf[2];
        qf[0] = qn[0]; qf[1] = qn[1];
        if (c + 1 < 32) {
#pragma unroll
            for (int i = 0; i < 2; ++i) {
                rk[i] = *(const u32x4*)(ksrc + (t0 + 64 + r0 + 32 * i) * ld + c8);
                rv[i] = *(const u32x4*)(vsrc + (t0 + 64 + r0 + 32 * i) * ld + c8);
            }
#pragma unroll
            for (int ks = 0; ks < 2; ++ks)
                qn[ks] = *(const bf16x8*)(qsrc + (t0 + 64 + 16 * w + li) * ld + ks * 32 + g * 8);
        }
        u16 e1[4][4], e2[4][4];
#pragma unroll
        for (int j = 0; j < 4; ++j) {
            const int row = t0 + 16 * w + 4 * g + j;
#pragma unroll
            for (int nb = 0; nb < 4; ++nb) {
                if (SSD) {
                    e1[nb][j] = cv[row * 768 + h * 64 + nb * 16 + li];
                    e2[nb][j] = proj[row * NPROJ + C_Z + h * 64 + nb * 16 + li];
                } else {
                    e1[nb][j] = proj[row * NPROJ + C_RG + h * 64 + nb * 16 + li];
                    e2[nb][j] = 0;
                }
            }
        }
        f32x4 st[4];
#pragma unroll
        for (int kb = 0; kb < 4; ++kb) {
            st[kb] = f32x4{0.f, 0.f, 0.f, 0.f};
            if (kb <= w) {
#pragma unroll
                for (int ks = 0; ks < 2; ++ks) {
                    const bf16x8 a = *(const bf16x8*)(sK + (kb * 16 + li) * 72 + ks * 32 + g * 8);
                    st[kb] = __builtin_amdgcn_mfma_f32_16x16x32_bf16(a, qf[ks], st[kb], 0, 0, 0);
                }
            }
        }
        if (SSD) {
            const float acl = sAc[16 * w + li];
#pragma unroll
            for (int kb = 0; kb < 4; ++kb) {
                const f32x4 acs = *(const f32x4*)(sAc + kb * 16 + 4 * g);
#pragma unroll
                for (int j = 0; j < 4; ++j) {
                    const int d = (16 * w + li) - (kb * 16 + 4 * g + j);
                    st[kb][j] = d >= 0 ? st[kb][j] * __expf(acl - acs[j]) : 0.f;
                }
            }
        } else {
#pragma unroll
            for (int kb = 0; kb < 4; ++kb)
#pragma unroll
                for (int j = 0; j < 4; ++j) {
                    const int d = (16 * w + li) - (kb * 16 + 4 * g + j);
                    st[kb][j] = d >= 0 ? st[kb][j] * exp2f((float)d * lg) : 0.f;
                }
        }
        f32x4 o[4], oc[4];
#pragma unroll
        for (int nb = 0; nb < 4; ++nb) { o[nb] = f32x4{0.f, 0.f, 0.f, 0.f}; oc[nb] = f32x4{0.f, 0.f, 0.f, 0.f}; }
#pragma unroll
        for (int cc = 0; cc < 2; ++cc) {
            union { bf16x8 v; unsigned u[4]; } pa;
            pa.u[0] = pack2(st[2 * cc][0], st[2 * cc][1]);
            pa.u[1] = pack2(st[2 * cc][2], st[2 * cc][3]);
            pa.u[2] = pack2(st[2 * cc + 1][0], st[2 * cc + 1][1]);
            pa.u[3] = pack2(st[2 * cc + 1][2], st[2 * cc + 1][3]);
#pragma unroll
            for (int nb = 0; nb < 4; ++nb) {
                const bf16x8 bv = tr_pair(sV, 2 * cc * 16 + 4 * g, (2 * cc + 1) * 16 + 4 * g, nb * 16, 72, li);
                o[nb] = __builtin_amdgcn_mfma_f32_16x16x32_bf16(pa.v, bv, o[nb], 0, 0, 0);
            }
        }
#pragma unroll
        for (int ks = 0; ks < 2; ++ks)
#pragma unroll
            for (int nb = 0; nb < 4; ++nb) {
                const bf16x8 sb = *(const bf16x8*)(sSt + (nb * 16 + li) * 72 + ks * 32 + g * 8);
                oc[nb] = __builtin_amdgcn_mfma_f32_16x16x32_bf16(qf[ks], sb, oc[nb], 0, 0, 0);
            }
        {
            f32x4 dl[4];
#pragma unroll
            for (int n = 0; n < 4; ++n) dl[n] = f32x4{0.f, 0.f, 0.f, 0.f};
#pragma unroll
            for (int ks = 0; ks < 2; ++ks) {
                const bf16x8 av = tr_pair(sVd, ks * 32 + 8 * g, ks * 32 + 8 * g + 4, 16 * w, 72, li);
#pragma unroll
                for (int n = 0; n < 4; ++n) {
                    const bf16x8 bk = tr_pair(sK, ks * 32 + 8 * g, ks * 32 + 8 * g + 4, n * 16, 72, li);
                    dl[n] = __builtin_amdgcn_mfma_f32_16x16x32_bf16(av, bk, dl[n], 0, 0, 0);
                }
            }
            const float sd = SSD ? __expf(aclast) : sdecR;
#pragma unroll
            for (int n = 0; n < 4; ++n)
#pragma unroll
                for (int j = 0; j < 4; ++j) accs[n][j] = accs[n][j] * sd + dl[n][j];
        }
        if (SSD) {
            u16* ys = (u16*)(p.ws + OFF_YS) + (size_t)b * S_ * 512;
            const float Dk = p.ssd_d[L * 8 + h];
#pragma unroll
            for (int j = 0; j < 4; ++j) {
                const int lq = 16 * w + 4 * g + j;
                const float ea = __expf(sAc[lq]);
#pragma unroll
                for (int nb = 0; nb < 4; ++nb) {
                    const float y = o[nb][j] + ea * oc[nb][j] + Dk * bf2f(e1[nb][j]);
                    ys[(t0 + lq) * 512 + h * 64 + nb * 16 + li] = f2bf(y * siluf(bf2f(e2[nb][j])));
                }
            }
        } else {
            u16* ys = (u16*)(p.ws + OFF_YS) + (size_t)1 * T_ * 512 + (size_t)b * S_ * 512;
#pragma unroll
            for (int j = 0; j < 4; ++j) {
                float yv[4], sm = 0.f;
#pragma unroll
                for (int nb = 0; nb < 4; ++nb) { yv[nb] = o[nb][j] + crs[j] * oc[nb][j]; sm += yv[nb]; }
                sm += __shfl_xor(sm, 1); sm += __shfl_xor(sm, 2); sm += __shfl_xor(sm, 4); sm += __shfl_xor(sm, 8);
                const float mu = sm * (1.f / 64.f);
                float vs = 0.f;
#pragma unroll
                for (int nb = 0; nb < 4; ++nb) { yv[nb] -= mu; vs += yv[nb] * yv[nb]; }
                vs += __shfl_xor(vs, 1); vs += __shfl_xor(vs, 2); vs += __shfl_xor(vs, 4); vs += __shfl_xor(vs, 8);
                const float rstd = rsqrtf(vs * (1.f / 64.f) + 1e-6f);
                const int lq = 16 * w + 4 * g + j;
#pragma unroll
                for (int nb = 0; nb < 4; ++nb) {
                    const float gn = p.ret_norm[L * 512 + h * 64 + nb * 16 + li];
                    ys[(t0 + lq) * 512 + h * 64 + nb * 16 + li] = f2bf(siluf(bf2f(e1[nb][j])) * yv[nb] * rstd * gn);
                }
            }
        }
    }
}

__device__ __forceinline__ void ssd_item(const Ctx& X, const Params& p, int L, int b, int hg, char* smem) {
    const int lane = X.tid & 63, w = X.tid >> 6;
    const int h = hg * 4 + w, g = h >> 2;
    float* sBC = (float*)smem + w * 128;
    const u16* proj = (const u16*)(p.ws + OFF_PROJ) + (size_t)b * S_ * NPROJ;
    const float* dtr = (const float*)(p.ws + OFF_DT) + (size_t)b * S_ * 8;
    float* tmp = (float*)(p.ws + OFF_MERGED) + (size_t)b * S_ * 512;
    const float* cw = p.conv_w + (size_t)L * 4 * 768;
    const float* cb = p.conv_b + (size_t)L * 768;
    const int cx = h * 64 + lane, cB = 512 + g * 64 + lane, cC = 640 + g * 64 + lane;
    float wx[4], wB[4], wC[4];
#pragma unroll
    for (int k = 0; k < 4; ++k) { wx[k] = cw[k * 768 + cx]; wB[k] = cw[k * 768 + cB]; wC[k] = cw[k * 768 + cC]; }
    const float bx = cb[cx], bB = cb[cB], bC = cb[cC];
    const float dtb = p.dt_bias[L * 8 + h], A = -expf(p.a_log[L * 8 + h]), Dk = p.ssd_d[L * 8 + h];
    float st[64];
#pragma unroll
    for (int n = 0; n < 64; ++n) st[n] = 0.f;
    float x1 = 0.f, x2 = 0.f, x3 = 0.f, B1 = 0.f, B2 = 0.f, B3 = 0.f, C1 = 0.f, C2 = 0.f, C3 = 0.f;
    float nx = bf2f(proj[C_XBC + cx]), nB = bf2f(proj[C_XBC + cB]), nC = bf2f(proj[C_XBC + cC]);
    float nz = bf2f(proj[C_Z + cx]), ndt = dtr[h];
    for (int s = 0; s < S_; ++s) {
        const float x0 = nx, B0 = nB, C0 = nC, z = nz, dtraw = ndt;
        if (s + 1 < S_) {
            const u16* pr = proj + (size_t)(s + 1) * NPROJ;
            nx = bf2f(pr[C_XBC + cx]); nB = bf2f(pr[C_XBC + cB]); nC = bf2f(pr[C_XBC + cC]);
            nz = bf2f(pr[C_Z + cx]); ndt = dtr[(s + 1) * 8 + h];
        }
        const float xs = siluf(bx + wx[0] * x3 + wx[1] * x2 + wx[2] * x1 + wx[3] * x0);
        const float Bv = siluf(bB + wB[0] * B3 + wB[1] * B2 + wB[2] * B1 + wB[3] * B0);
        const float Cv = siluf(bC + wC[0] * C3 + wC[1] * C2 + wC[2] * C1 + wC[3] * C0);
        x3 = x2; x2 = x1; x1 = x0; B3 = B2; B2 = B1; B1 = B0; C3 = C2; C2 = C1; C1 = C0;
        __syncthreads();
        sBC[lane] = Bv;
        sBC[64 + lane] = Cv;
        __syncthreads();
        const float dt = softplusf(dtraw + dtb);
        const float a = __expf(dt * A);
        const float xdt = xs * dt;
        float y = 0.f;
#pragma unroll
        for (int n = 0; n < 64; n += 4) {
            const float4 b4 = *(const float4*)(sBC + n);
            const float4 c4 = *(const float4*)(sBC + 64 + n);
            st[n] = st[n] * a + b4.x * xdt; y += c4.x * st[n];
            st[n + 1] = st[n + 1] * a + b4.y * xdt; y += c4.y * st[n + 1];
            st[n + 2] = st[n + 2] * a + b4.z * xdt; y += c4.z * st[n + 2];
            st[n + 3] = st[n + 3] * a + b4.w * xdt; y += c4.w * st[n + 3];
        }
        y += Dk * xs;
        tmp[(size_t)s * 512 + cx] = y * siluf(z);
    }
}

__device__ __forceinline__ void ret_item(const Ctx& X, const Params& p, int L, int b, int hg, char* smem) {
    const int lane = X.tid & 63, w = X.tid >> 6;
    const int h = hg * 4 + w;
    float* sQK = (float*)smem + w * 128;
    const u16* proj = (const u16*)(p.ws + OFF_PROJ) + (size_t)b * S_ * NPROJ;
    u16* ys = (u16*)(p.ws + OFF_YS) + (size_t)1 * T_ * 512 + (size_t)b * S_ * 512;
    const float gamma = 1.f - exp2f(-5.f - (float)h);
    const float gn = p.ret_norm[L * 512 + h * 64 + lane];
    float st[64];
#pragma unroll
    for (int d = 0; d < 64; ++d) st[d] = 0.f;
    const int c = h * 64 + lane;
    float nq = bf2f(proj[C_RQ + c]), nk = bf2f(proj[C_RK + c]), nv = bf2f(proj[C_RV + c]), ng = bf2f(proj[C_RG + c]);
    for (int s = 0; s < S_; ++s) {
        const float q = nq, k = nk, v = nv, gg = ng;
        if (s + 1 < S_) {
            const u16* pr = proj + (size_t)(s + 1) * NPROJ;
            nq = bf2f(pr[C_RQ + c]); nk = bf2f(pr[C_RK + c]); nv = bf2f(pr[C_RV + c]); ng = bf2f(pr[C_RG + c]);
        }
        __syncthreads();
        sQK[lane] = q;
        sQK[64 + lane] = k;
        __syncthreads();
        float y = 0.f;
#pragma unroll
        for (int d = 0; d < 64; d += 4) {
            const float4 q4 = *(const float4*)(sQK + d);
            const float4 k4 = *(const float4*)(sQK + 64 + d);
            st[d] = st[d] * gamma + k4.x * v; y += q4.x * st[d];
            st[d + 1] = st[d + 1] * gamma + k4.y * v; y += q4.y * st[d + 1];
            st[d + 2] = st[d + 2] * gamma + k4.z * v; y += q4.z * st[d + 2];
            st[d + 3] = st[d + 3] * gamma + k4.w * v; y += q4.w * st[d + 3];
        }
        const float mu = wsum(y) * (1.f / 64.f);
        const float dv = y - mu;
        const float var = wsum(dv * dv) * (1.f / 64.f);
        const float yn = dv * rsqrtf(var + 1e-6f) * gn;
        ys[(size_t)s * 512 + c] = f2bf(siluf(gg) * yn);
    }
}

__device__ __forceinline__ void phase_mixers(const Ctx& X, const Params& p, int L, char* smem) {
    for (int it = X.bid; it < 128; it += X.nb) {
        if (it < 64) linattn_item<true>(X, p, L, it >> 3, it & 7, smem);
        else linattn_item<false>(X, p, L, (it - 64) >> 3, it & 7, smem);
    }
    __syncthreads();
    phase_moba(X, p, smem);
    __syncthreads();
    phase_dil(X, p, smem);
}

__device__ __forceinline__ void phase_ssdnorm(const Ctx& X, const Params& p, int L) {
    const int lane = X.tid & 63, wid = X.tid >> 6;
    u16* ys = (u16*)(p.ws + OFF_YS);
    const float* gain = p.ssd_norm + L * 512;
    for (int t = X.bid * 4 + wid; t < T_; t += X.nb * 4) {
        const u32x4 v = *(const u32x4*)(ys + (size_t)t * 512 + lane * 8);
        float f[8];
        float ss = 0.f;
#pragma unroll
        for (int i = 0; i < 4; ++i) {
            f[2 * i] = __uint_as_float(v[i] << 16);
            f[2 * i + 1] = __uint_as_float(v[i] & 0xffff0000u);
            ss += f[2 * i] * f[2 * i] + f[2 * i + 1] * f[2 * i + 1];
        }
        ss = wsum(ss);
        const float r = rsqrtf(ss * (1.f / 512.f) + 1e-6f);
        u32x4 o;
#pragma unroll
        for (int i = 0; i < 4; ++i)
            o[i] = pack2(f[2 * i] * r * gain[lane * 8 + 2 * i], f[2 * i + 1] * r * gain[lane * 8 + 2 * i + 1]);
        *(u32x4*)(ys + (size_t)t * 512 + lane * 8) = o;
    }
}

__device__ __forceinline__ void phase_xattn(const Ctx& X, const Params& p, int L, char* smem) {
    const int tid = X.tid, lane = tid & 63, w = tid >> 6, li = lane & 15, g = lane >> 4;
    u16* sV = (u16*)smem;
    const u16* xq = (const u16*)(p.ws + OFF_XQ);
    const u16* kv = (const u16*)(p.ws + OFF_XKV) + (size_t)L * 2048 * 2048;
    u16* xo = (u16*)(p.ws + OFF_XO);
    for (int it = X.bid; it < 1024; it += X.nb) {
        const int qt = it & 31, hx = (it >> 5) & 3, b = it >> 7;
        const size_t qrow = (size_t)b * S_ + qt * 64 + 16 * w + li;
        bf16x8 qf[8];
#pragma unroll
        for (int ks = 0; ks < 8; ++ks) qf[ks] = *(const bf16x8*)(xq + qrow * 1024 + hx * 256 + ks * 32 + g * 8);
        FlashStateT<16> fs;
        fs.m = -1e30f; fs.l = 0.f;
#pragma unroll
        for (int nb = 0; nb < 16; ++nb) fs.o[nb] = f32x4{0.f, 0.f, 0.f, 0.f};
        const u16* kbase = kv + (size_t)b * 256 * 2048 + hx * 256;
        const u16* vbase = kbase + 1024;
        for (int kt = 0; kt < 4; ++kt) {
            __syncthreads();
#pragma unroll
            for (int i = 0; i < 8; ++i) {
                const int ch = tid + i * 256, r = ch >> 5, c8 = (ch & 31) * 8;
                *(u32x4*)(sV + r * 264 + c8) = *(const u32x4*)(vbase + (size_t)(kt * 64 + r) * 2048 + c8);
            }
            __syncthreads();
            f32x4 st[4];
#pragma unroll
            for (int kb = 0; kb < 4; ++kb) {
                st[kb] = f32x4{0.f, 0.f, 0.f, 0.f};
#pragma unroll
                for (int ks = 0; ks < 8; ++ks) {
                    const bf16x8 a = *(const bf16x8*)(kbase + (size_t)(kt * 64 + kb * 16 + li) * 2048 + ks * 32 + g * 8);
                    st[kb] = __builtin_amdgcn_mfma_f32_16x16x32_bf16(a, qf[ks], st[kb], 0, 0, 0);
                }
#pragma unroll
                for (int j = 0; j < 4; ++j) st[kb][j] *= 0.0625f;
            }
            flash_update<16>(st, fs, sV, 264, li, g);
        }
#pragma unroll
        for (int j = 0; j < 4; ++j) {
            const float inv = 1.f / __shfl(fs.l, 4 * g + j);
            const size_t row = (size_t)b * S_ + qt * 64 + 16 * w + 4 * g + j;
#pragma unroll
            for (int nb = 0; nb < 16; ++nb) xo[row * 1024 + hx * 256 + nb * 16 + li] = f2bf(fs.o[nb][j] * inv);
        }
    }
}

__device__ __forceinline__ void wargmax(float& v, int& i) {
#pragma unroll
    for (int o = 32; o > 0; o >>= 1) {
        const float ov = __shfl_xor(v, o);
        const int oi = __shfl_xor(i, o);
        if (ov > v || (ov == v && oi < i)) { v = ov; i = oi; }
    }
}

__device__ __forceinline__ void phase_peer_select(const Ctx& X, const Params& p, int L) {
    const int tid = X.tid, lane = tid & 63, w = tid >> 6, li = lane & 15, g = lane >> 4;
    const u16* pq = (const u16*)(p.ws + OFF_PQ);
    int* seli = (int*)(p.ws + OFF_SELI);
    float* selg = (float*)(p.ws + OFF_SELG);
    const u16* keys = (const u16*)(p.ws + OFF_KEYS) + (size_t)L * 8 * 2 * 128 * 128;
    for (int it = X.bid; it < 256 * 8; it += X.nb) {
        const int hh = it & 7, t0 = (it >> 3) * 64 + 16 * w;
        float tv0[16], tv1[16];
        unsigned ti0[4] = {0u, 0u, 0u, 0u}, ti1[4] = {0u, 0u, 0u, 0u};
#pragma unroll
        for (int pp = 0; pp < 2; ++pp) {
            bf16x8 qf[4];
#pragma unroll
            for (int ks = 0; ks < 4; ++ks)
                qf[ks] = *(const bf16x8*)(pq + (size_t)(t0 + li) * 2048 + hh * 256 + pp * 128 + ks * 32 + g * 8);
            const u16* kbase = keys + (size_t)(hh * 2 + pp) * 128 * 128;
            f32x4 sc[8];
#pragma unroll
            for (int kb = 0; kb < 8; ++kb) {
                sc[kb] = f32x4{0.f, 0.f, 0.f, 0.f};
#pragma unroll
                for (int ks = 0; ks < 4; ++ks) {
                    const bf16x8 a = *(const bf16x8*)(kbase + (kb * 16 + li) * 128 + ks * 32 + g * 8);
                    sc[kb] = __builtin_amdgcn_mfma_f32_16x16x32_bf16(a, qf[ks], sc[kb], 0, 0, 0);
                }
            }
#pragma unroll
            for (int r = 0; r < 16; ++r) {
                float bv = -INFINITY;
                int bk = 0x7fffffff;
#pragma unroll
                for (int kb = 0; kb < 8; ++kb)
#pragma unroll
                    for (int j = 0; j < 4; ++j) {
                        const bool gt = sc[kb][j] > bv;
                        bv = gt ? sc[kb][j] : bv;
                        bk = gt ? (kb * 16 + 4 * g + j) : bk;
                    }
#pragma unroll
                for (int o = 16; o <= 32; o <<= 1) {
                    const float ov = __shfl_xor(bv, o);
                    const int ok = __shfl_xor(bk, o);
                    const bool tk = (ov > bv) || (ov == bv && ok < bk);
                    bv = tk ? ov : bv;
                    bk = tk ? ok : bk;
                }
                if (pp == 0) { tv0[r] = bv; ti0[r >> 2] |= (unsigned)bk << (8 * (r & 3)); }
                else { tv1[r] = bv; ti1[r >> 2] |= (unsigned)bk << (8 * (r & 3)); }
#pragma unroll
                for (int kb = 0; kb < 8; ++kb)
#pragma unroll
                    for (int j = 0; j < 4; ++j) sc[kb][j] = (kb * 16 + 4 * g + j == bk) ? -INFINITY : sc[kb][j];
            }
        }
        float cs0[16], cs1[3], cs2, cs3;
        {
            const float sa0 = (g == 0) ? tv0[0] : (g == 1) ? tv0[1] : (g == 2) ? tv0[2] : tv0[3];
            const float sa1 = (g == 0) ? tv0[4] : (g == 1) ? tv0[5] : (g == 2) ? tv0[6] : tv0[7];
            const float sa2 = (g == 0) ? tv0[8] : (g == 1) ? tv0[9] : (g == 2) ? tv0[10] : tv0[11];
            const float sa3 = (g == 0) ? tv0[12] : (g == 1) ? tv0[13] : (g == 2) ? tv0[14] : tv0[15];
#pragma unroll
            for (int bq = 0; bq < 16; ++bq) cs0[bq] = sa0 + tv1[bq];
#pragma unroll
            for (int bq = 0; bq < 3; ++bq) cs1[bq] = sa1 + tv1[bq];
            cs2 = sa2 + tv1[0];
            cs3 = sa3 + tv1[0];
        }
        float bs[16];
        unsigned bc[4] = {0u, 0u, 0u, 0u};
#pragma unroll
        for (int r = 0; r < 16; ++r) {
            float bv = -INFINITY;
            int bk = 0x7fffffff;
#define CAND(v, c) { const bool gt = (v) > bv; bv = gt ? (v) : bv; bk = gt ? (c) : bk; }
#pragma unroll
            for (int bq = 0; bq < 16; ++bq) CAND(cs0[bq], g * 16 + bq)
#pragma unroll
            for (int bq = 0; bq < 3; ++bq) CAND(cs1[bq], (g + 4) * 16 + bq)
            CAND(cs2, (g + 8) * 16)
            CAND(cs3, (g + 12) * 16)
#undef CAND
#pragma unroll
            for (int o = 16; o <= 32; o <<= 1) {
                const float ov = __shfl_xor(bv, o);
                const int ok = __shfl_xor(bk, o);
                const bool tk = (ov > bv) || (ov == bv && ok < bk);
                bv = tk ? ov : bv;
                bk = tk ? ok : bk;
            }
            bs[r] = bv;
            bc[r >> 2] |= (unsigned)bk << (8 * (r & 3));
#pragma unroll
            for (int bq = 0; bq < 16; ++bq) cs0[bq] = (g * 16 + bq == bk) ? -INFINITY : cs0[bq];
#pragma unroll
            for (int bq = 0; bq < 3; ++bq) cs1[bq] = ((g + 4) * 16 + bq == bk) ? -INFINITY : cs1[bq];
            cs2 = ((g + 8) * 16 == bk) ? -INFINITY : cs2;
            cs3 = ((g + 12) * 16 == bk) ? -INFINITY : cs3;
        }
        float es = 0.f;
#pragma unroll
        for (int r = 0; r < 16; ++r) es += __expf(bs[r] - bs[0]);
        const float inv = 1.f / es;
        int oi[4];
        float og[4];
        const unsigned bcw = (g == 0) ? bc[0] : (g == 1) ? bc[1] : (g == 2) ? bc[2] : bc[3];
#pragma unroll
        for (int q = 0; q < 4; ++q) {
            const int c = (bcw >> (8 * q)) & 255;
            const float bsv = (g == 0) ? bs[q] : (g == 1) ? bs[4 + q] : (g == 2) ? bs[8 + q] : bs[12 + q];
            const int a = c >> 4, bq = c & 15;
            const unsigned wa = ((a >> 2) == 0) ? ti0[0] : ((a >> 2) == 1) ? ti0[1] : ((a >> 2) == 2) ? ti0[2] : ti0[3];
            const unsigned wb = ((bq >> 2) == 0) ? ti1[0] : ((bq >> 2) == 1) ? ti1[1] : ((bq >> 2) == 2) ? ti1[2] : ti1[3];
            const int ia = (wa >> (8 * (a & 3))) & 255, ib = (wb >> (8 * (bq & 3))) & 255;
            oi[q] = ia * 128 + ib;
            og[q] = __expf(bsv - bs[0]) * inv;
        }
        *(int4*)(seli + (size_t)(t0 + li) * 128 + hh * 16 + 4 * g) = make_int4(oi[0], oi[1], oi[2], oi[3]);
        *(float4*)(selg + (size_t)(t0 + li) * 128 + hh * 16 + 4 * g) = make_float4(og[0], og[1], og[2], og[3]);
    }
}

__device__ __forceinline__ void phase_peer_convert(const Ctx& X, const Params& p, int L) {
    const float4* su = (const float4*)(p.peer_u + (size_t)L * NEXP * 1024);
    const float4* sv = (const float4*)(p.peer_v + (size_t)L * NEXP * 1024);
    u32x4* du = (u32x4*)(p.ws + OFF_PU);
    u32x4* dv = (u32x4*)(p.ws + OFF_PV);
    for (size_t e = (size_t)X.bid * 256 + X.tid; e < (size_t)NEXP * 128; e += (size_t)X.nb * 256) {
        const float4 a0 = su[2 * e], a1 = su[2 * e + 1], b0 = sv[2 * e], b1 = sv[2 * e + 1];
        u32x4 o;
        o[0] = pack2(a0.x, a0.y); o[1] = pack2(a0.z, a0.w); o[2] = pack2(a1.x, a1.y); o[3] = pack2(a1.z, a1.w);
        du[e] = o;
        o[0] = pack2(b0.x, b0.y); o[1] = pack2(b0.z, b0.w); o[2] = pack2(b1.x, b1.y); o[3] = pack2(b1.z, b1.w);
        dv[e] = o;
    }
}

__device__ __forceinline__ void phase_peer_apply(const Ctx& X, const Params& p, int L, char* smem, bool dry = false) {
    const int tid = X.tid, lane = tid & 63, w = tid >> 6, li = lane & 15, g = lane >> 4;
    u16* sX = (u16*)smem + w * 1024;
    const u16* hn = (const u16*)(p.ws + OFF_HN);
    const int* seli = (const int*)(p.ws + OFF_SELI);
    const float* selg = (const float*)(p.ws + OFF_SELG);
    float* h = (float*)(p.ws + (dry ? OFF_XQ : OFF_H));
    const u16* PU = (const u16*)(p.ws + OFF_PU);
    const u16* PV = (const u16*)(p.ws + OFF_PV);
    const int nIter = (T_ + X.nb * 4 - 1) / (X.nb * 4);
    for (int tt = 0; tt < nIter; ++tt) {
        const int t = (tt * X.nb + X.bid) * 4 + w;
        const bool act_t = t < T_;
        const int tc = act_t ? t : T_ - 1;
        __syncthreads();
        *(u32x4*)(sX + lane * 8) = *(const u32x4*)(hn + (size_t)tc * 1024 + lane * 8);
        *(u32x4*)(sX + 512 + lane * 8) = *(const u32x4*)(hn + (size_t)tc * 1024 + 512 + lane * 8);
        __syncthreads();
        float y[16];
#pragma unroll
        for (int i = 0; i < 16; ++i) y[i] = 0.f;
#pragma unroll 1
        for (int gr = 0; gr < 8; ++gr) {
            const int idx = seli[(size_t)tc * 128 + gr * 16 + li];
            const f32x4 gate = *(const f32x4*)(selg + (size_t)tc * 128 + gr * 16 + 4 * g);
            const u16* urow = PU + (size_t)idx * 1024 + g * 256;
            f32x4 acc = f32x4{0.f, 0.f, 0.f, 0.f};
#pragma unroll 8
            for (int kk = 0; kk < 32; ++kk) {
                const bf16x8 a = *(const bf16x8*)(urow + kk * 8);
                const bf16x8 bx = *(const bf16x8*)(sX + g * 256 + kk * 8);
                acc = __builtin_amdgcn_mfma_f32_16x16x32_bf16(a, bx, acc, 0, 0, 0);
            }
            float actv[4];
#pragma unroll
            for (int j = 0; j < 4; ++j) {
                const float a = acc[j];
                actv[j] = 0.5f * a * (1.f + erff(a * 0.70710678118654752f)) * gate[j];
            }
#pragma unroll 1
            for (int eh = 0; eh < 2; ++eh) {
#pragma unroll
                for (int e8 = 0; e8 < 8; ++e8) {
                    const float ae = __int_as_float(__builtin_amdgcn_readlane(__float_as_int(actv[e8 & 3]), 16 * (2 * eh + (e8 >> 2))));
                    const int ie = __builtin_amdgcn_readlane(idx, eh * 8 + e8);
                    const u16* vrow = PV + (size_t)ie * 1024;
                    const u32x4 v0 = *(const u32x4*)(vrow + lane * 8);
                    const u32x4 v1 = *(const u32x4*)(vrow + 512 + lane * 8);
#pragma unroll
                    for (int q = 0; q < 4; ++q) {
                        y[2 * q] += ae * __uint_as_float(v0[q] << 16);
                        y[2 * q + 1] += ae * __uint_as_float(v0[q] & 0xffff0000u);
                        y[8 + 2 * q] += ae * __uint_as_float(v1[q] << 16);
                        y[8 + 2 * q + 1] += ae * __uint_as_float(v1[q] & 0xffff0000u);
                    }
                }
            }
        }
        if (act_t) {
            float4* hr = (float4*)(h + (size_t)t * 1024);
#pragma unroll
            for (int c = 0; c < 2; ++c) {
#pragma unroll
                for (int q = 0; q < 2; ++q) {
                    float4 hv = hr[c * 128 + lane * 2 + q];
                    hv.x += y[c * 8 + q * 4 + 0]; hv.y += y[c * 8 + q * 4 + 1];
                    hv.z += y[c * 8 + q * 4 + 2]; hv.w += y[c * 8 + q * 4 + 3];
                    hr[c * 128 + lane * 2 + q] = hv;
                }
            }
        }
    }
}

#define XB_TMO      128
#define XB_XCNT(j)  (256  + 64 * (j))
#define XB_XSUB(j)  (1280 + 64 * (j))
#define XB_XGEN(j)  (2304 + 64 * (j))
#define XB_TOP      3328
#define XB_TOPGEN   3392
#define XCD_BAR_WORDS 3456
#define XB_SPIN_CAP (1u << 27)
#define LAS __attribute__((address_space(3)))
__device__ __forceinline__ unsigned xb_ld(unsigned* p) { return __hip_atomic_load(p, __ATOMIC_RELAXED, __HIP_MEMORY_SCOPE_AGENT); }
__device__ __forceinline__ unsigned xb_add(unsigned* p, unsigned v) { return __hip_atomic_fetch_add(p, v, __ATOMIC_RELAXED, __HIP_MEMORY_SCOPE_AGENT); }
__device__ __forceinline__ unsigned xb_xcc_id() { return (unsigned)__builtin_amdgcn_s_getreg((3 << 11) | 20) & 0xFu; }
#define XB_SPIN(cond, bar) do { unsigned _sp = 0; while (cond) { __builtin_amdgcn_s_sleep(1); \
    if ((++_sp & 255u) == 0u) { if (xb_ld(&(bar)[XB_TMO])) break; if (_sp > XB_SPIN_CAP) { atomicAdd(&(bar)[XB_TMO], 1u); break; } } } } while (0)
struct XcdBarrier {
    unsigned* bar; unsigned x;
    volatile LAS unsigned* st;
};
__device__ __forceinline__ XcdBarrier xcd_barrier_post(unsigned* bar, volatile LAS unsigned* st) {
    XcdBarrier b; b.bar = bar; b.x = xb_xcc_id(); b.st = st;
    if (threadIdx.x == 0) (void)xb_add(&bar[XB_XCNT(b.x)], 1u);
    return b;
}
__device__ __forceinline__ void xcd_barrier_complete(unsigned* bar, unsigned x, unsigned& nloc, unsigned& nx) {
    const unsigned G = gridDim.x * gridDim.y * gridDim.z;
    unsigned sum, cnt, mine, sp = 0u;
    for (;;) {
        sum = 0u; cnt = 0u; mine = 0u;
#pragma unroll
        for (unsigned j = 0; j < 16; ++j) { const unsigned c = xb_ld(&bar[XB_XCNT(j)]); sum += c; cnt += (c > 0u) ? 1u : 0u; mine = (j == x) ? c : mine; }
        if (sum == G) break;
        __builtin_amdgcn_s_sleep(1);
        if ((++sp & 255u) == 0u) { if (xb_ld(&bar[XB_TMO])) break; if (sp > XB_SPIN_CAP) { atomicAdd(&bar[XB_TMO], 1u); break; } }
    }
    nloc = mine > 0u ? mine : 1u; nx = cnt > 0u ? cnt : 1u;
}
__device__ __forceinline__ void xcd_barrier(const XcdBarrier& b) {
    asm volatile("s_waitcnt vmcnt(0)" ::: "memory");
    __syncthreads();
    if (threadIdx.x == 0) {
        unsigned* bar = b.bar;
        __builtin_amdgcn_s_waitcnt(0);
        unsigned nloc = b.st[0], nx = b.st[1];
        if (nloc == 0u) { xcd_barrier_complete(bar, b.x, nloc, nx); b.st[0] = nloc; b.st[1] = nx; }
        const unsigned old = xb_add(&bar[XB_XSUB(b.x)], 1u);
        const unsigned gen = old / nloc;
        if (old + 1u == (gen + 1u) * nloc) {
            __builtin_amdgcn_fence(__ATOMIC_RELEASE, "agent");
            asm volatile("s_waitcnt vmcnt(0)" ::: "memory");
            const unsigned og = xb_add(&bar[XB_TOP], 1u);
            const unsigned tg = og / nx;
            if (og + 1u == (tg + 1u) * nx) xb_add(&bar[XB_TOPGEN], 1u);
            else XB_SPIN(xb_ld(&bar[XB_TOPGEN]) == tg, bar);
            __builtin_amdgcn_fence(__ATOMIC_ACQUIRE, "agent");
            xb_add(&bar[XB_XGEN(b.x)], 1u);
            asm volatile("s_waitcnt vmcnt(0)" ::: "memory");
        } else {
            XB_SPIN(xb_ld(&bar[XB_XGEN(b.x)]) == gen, bar);
            __builtin_amdgcn_fence(__ATOMIC_ACQUIRE, "agent");
            asm volatile("s_waitcnt vmcnt(0)" ::: "memory");
        }
    }
    __syncthreads();
}

enum { OP_PROLOGUE = 0, OP_XKV, OP_NORM1, OP_GEMM_PROJ, OP_KMEAN, OP_MIXERS, OP_SSDNORM, OP_MERGE, OP_GEMM_OUT, OP_NORM2,
       OP_GEMM_XQ, OP_XATTN, OP_GEMM_XO, OP_NORM3, OP_GEMM_PQ, OP_PSEL, OP_PAPPLY, OP_FINAL };
constexpr int N_PHASES = 2 + 2 * 15 + 1;

__device__ __forceinline__ void run_phase(const Ctx& X, const Params& p, int ph, char* smem) {
    char* ws = p.ws;
    int op, L = 0;
    if (ph < 2) op = ph;
    else if (ph == N_PHASES - 1) op = OP_FINAL;
    else { L = (ph - 2) / 15; op = OP_NORM1 + (ph - 2) % 15; }
    const char* wl = ws + OFF_W + L * W_LAYER;
    switch (op) {
    case OP_PROLOGUE: phase_prologue(X, p, smem); break;
    case OP_XKV:
        for (int l2 = 0; l2 < 2; ++l2)
            phase_gemm<EPI_BF16>(X, p, (const u16*)(ws + OFF_MEMB), 1024, (const u16*)(ws + OFF_W + l2 * W_LAYER + W_XKV),
                                 2048, 2048, 1024, (u16*)(ws + OFF_XKV) + (size_t)l2 * 2048 * 2048, 2048, smem);
        break;
    case OP_NORM1: phase_norm(X, p, p.mix_norm + L * 1024, (const float*)(ws + OFF_WDT) + L * 8 * 1024); break;
    case OP_GEMM_PROJ:
        phase_gemm<EPI_PROJ>(X, p, (const u16*)(ws + OFF_HN), 1024, (const u16*)(wl + W_IN), T_, NPROJ, 1024, ws + OFF_PROJ,
                             NPROJ, smem);
        break;
    case OP_KMEAN: phase_kmean(X, p); phase_premix(X, p, L); break;
    case OP_MIXERS: phase_mixers(X, p, L, smem); break;
    case OP_SSDNORM: phase_ssdnorm(X, p, L); phase_peer_convert(X, p, L); break;
    case OP_MERGE: phase_merge(X, p, L, smem); break;
    case OP_GEMM_OUT:
        phase_gemm<EPI_RESID>(X, p, (const u16*)(ws + OFF_MERGED), 1024, (const u16*)(wl + W_O), T_, 1024, 1024, ws + OFF_H,
                              1024, smem);
        break;
    case OP_NORM2: phase_norm(X, p, p.x_norm + L * 1024, nullptr); break;
    case OP_GEMM_XQ:
        phase_gemm<EPI_BF16>(X, p, (const u16*)(ws + OFF_HN), 1024, (const u16*)(wl + W_XQ), T_, 1024, 1024, ws + OFF_XQ,
                             1024, smem);
        break;
    case OP_XATTN: phase_xattn(X, p, L, smem); break;
    case OP_GEMM_XO:
        phase_gemm<EPI_RESID>(X, p, (const u16*)(ws + OFF_XO), 1024, (const u16*)(wl + W_XO), T_, 1024, 1024, ws + OFF_H,
                              1024, smem);
        break;
    case OP_NORM3: phase_norm(X, p, p.ffn_norm + L * 1024, nullptr); break;
    case OP_GEMM_PQ:
        phase_gemm<EPI_BF16>(X, p, (const u16*)(ws + OFF_HN), 1024, (const u16*)(wl + W_PQ), T_, 2048, 1024, ws + OFF_PQ,
                             2048, smem);
        break;
    case OP_PSEL: phase_peer_select(X, p, L); break;
    case OP_PAPPLY: phase_peer_apply(X, p, L, smem); break;
    default: phase_final(X, p); break;
    }
}

__global__ void __launch_bounds__(256, 2) mk_kernel(Params p, int ph_lo, int ph_hi) {
    cg::grid_group grid = cg::this_grid();
    __shared__ __attribute__((aligned(16))) char smem[SMEM_BYTES];
    __shared__ uint4 xb_words;
    if (threadIdx.x == 0) xb_words = make_uint4(0u, 0u, 0u, 0u);
    __syncthreads();
    const XcdBarrier xb = xcd_barrier_post((unsigned*)(p.ws + OFF_BAR), (volatile LAS unsigned*)&xb_words);
#pragma unroll 1
    for (int ph = ph_lo; ph < ph_hi; ++ph) {
        Ctx X;
        X.tid = threadIdx.x; X.bid = blockIdx.x; X.nb = gridDim.x;
        asm volatile("" : "+v"(X.tid));
        asm volatile("" : "+s"(X.bid));
        asm volatile("" : "+s"(X.nb));
        Params q = p;
        {
            long z = 0;
            asm volatile("" : "+s"(z));
            const char** qq = (const char**)&q;
#pragma unroll
            for (int i = 0; i < 25; ++i) qq[i] += z;
        }
        run_phase(X, q, ph, smem);
#ifdef REP_OP
        if (ph == REP_OP) {
            for (int rep = 0; rep < REP_N; ++rep) {
                xcd_barrier(xb);
                if (REP_OP == 2 + OP_PAPPLY - OP_NORM1) phase_peer_apply(X, q, 0, smem, true);
                else run_phase(X, q, ph, smem);
            }
        }
#endif
        if (ph + 1 < ph_hi) {
            if (ph == ph_lo) grid.sync();
            else xcd_barrier(xb);
        }
    }
}

extern "C" void kernel_launch(void* const* d_in, const int* in_sizes, int n_in, void* d_out, int out_size, void* d_ws,
                              size_t ws_size, hipStream_t stream) {
    static int grid_blocks = 0;
    if (!grid_blocks) {
        int dev = 0, cus = 0, per_cu = 0;
        (void)hipGetDevice(&dev);
        (void)hipDeviceGetAttribute(&cus, hipDeviceAttributeMultiprocessorCount, dev);
        (void)hipOccupancyMaxActiveBlocksPerMultiprocessor(&per_cu, mk_kernel, 256, 0);
        if (per_cu > 2) per_cu = 2;
        if (per_cu < 1) per_cu = 1;
        grid_blocks = cus * per_cu;
    }
    Params p{};
    const float** pp = (const float**)&p;
    for (int i = 0; i < 23; ++i) pp[i] = (const float*)d_in[i];
    p.out = (float*)d_out;
    p.ws = (char*)d_ws;
    if (ws_size < 512 * MiB) fprintf(stderr, "workspace too small: %zu\n", ws_size);
    int ph_lo = 0, ph_hi = N_PHASES;
    (void)hipMemsetAsync((char*)d_ws + OFF_BAR, 0, 16384, stream);
    void* args[] = {&p, &ph_lo, &ph_hi};
    hipError_t e = hipLaunchCooperativeKernel((void*)mk_kernel, dim3(grid_blocks), dim3(256), args, 0, stream);
    if (e != hipSuccess) fprintf(stderr, "cooperative launch failed: %s (grid %d)\n", hipGetErrorString(e), grid_blocks);
}
```

```cpp
#include <hip/hip_runtime.h>
#include <hip/hip_bf16.h>
#include <hip/hip_cooperative_groups.h>
#include <cstdio>
namespace cg = cooperative_groups;

typedef unsigned short u16;
using bf16x8 = __attribute__((ext_vector_type(8))) short;
using f32x4 = __attribute__((ext_vector_type(4))) float;
using u32x4 = __attribute__((ext_vector_type(4))) unsigned;

constexpr int T_ = 16384, S_ = 2048, B_ = 8, D_ = 1024;
constexpr int IN_DIM = 10504;
constexpr int NPROJ = 6400;
constexpr int C_Z = 0, C_XBC = 512, C_RQ = 1280, C_RK = 1792, C_RV = 2304, C_RG = 2816;
constexpr int C_MQ = 3328, C_MK = 3840, C_MV = 4352, C_DQ = 4864, C_DK = 5376, C_DV = 5888;
constexpr int NEXP = 16384;

constexpr size_t MiB = 1048576;
constexpr size_t OFF_H = 0;
constexpr size_t OFF_HN = 64 * MiB;
constexpr size_t OFF_PROJ = 96 * MiB;
constexpr size_t OFF_XQ = OFF_PROJ;
constexpr size_t OFF_XO = OFF_PROJ + 32 * MiB;
constexpr size_t OFF_PQ = OFF_PROJ + 64 * MiB;
constexpr size_t OFF_PU = OFF_PROJ + 128 * MiB;
constexpr size_t OFF_PV = OFF_PROJ + 144 * MiB;
constexpr size_t OFF_YS = 296 * MiB;
constexpr size_t OFF_MERGED = 360 * MiB;
constexpr size_t OFF_CONV = OFF_MERGED;
constexpr size_t OFF_DTV = OFF_MERGED + 24 * MiB;
constexpr size_t OFF_ACUM = OFF_DTV + (size_t)T_ * 8 * 4;
constexpr size_t OFF_W = 392 * MiB;
constexpr size_t W_IN = 0;
constexpr size_t W_G = W_IN + (size_t)6400 * 1024 * 2;
constexpr size_t W_B = W_G + (size_t)4096 * 1024 * 2;
constexpr size_t W_O = W_B + (size_t)4 * 1024 * 512 * 2;
constexpr size_t W_XQ = W_O + (size_t)1024 * 1024 * 2;
constexpr size_t W_XKV = W_XQ + (size_t)1024 * 1024 * 2;
constexpr size_t W_XO = W_XKV + (size_t)2048 * 1024 * 2;
constexpr size_t W_PQ = W_XO + (size_t)1024 * 1024 * 2;
constexpr size_t W_LAYER = W_PQ + (size_t)2048 * 1024 * 2;
constexpr size_t OFF_XKV = OFF_W + 2 * W_LAYER;
constexpr size_t OFF_SELI = OFF_XKV + 16 * MiB;
constexpr size_t OFF_SELG = OFF_SELI + 8 * MiB;
constexpr size_t OFF_DT = OFF_SELG + 8 * MiB;
constexpr size_t OFF_ROPE = OFF_DT + (size_t)T_ * 8 * 4;
constexpr size_t OFF_WDT = OFF_ROPE + (size_t)2048 * 64 * 4;
constexpr size_t OFF_KMEAN = OFF_WDT + (size_t)2 * 8 * 1024 * 4;
constexpr size_t OFF_MEMB = OFF_KMEAN + (size_t)8 * 8 * 8 * 64 * 4;
constexpr size_t OFF_BAR = OFF_MEMB + (size_t)2048 * 1024 * 2;
constexpr size_t OFF_KEYS = OFF_BAR + 16384;
constexpr size_t OFF_END = OFF_KEYS + (size_t)2 * 8 * 2 * 128 * 128 * 2;
static_assert(OFF_END <= 512 * MiB, "workspace overflow");

struct Params {
    const float *x, *mem, *mix_norm, *w_in, *conv_w, *conv_b, *dt_bias, *a_log, *ssd_d, *ssd_norm, *ret_norm,
        *w_branch, *w_out, *x_norm, *w_xq, *w_xkv, *w_xo, *ffn_norm, *w_pq, *sub_keys, *peer_u, *peer_v, *final_norm;
    float* out;
    char* ws;
};

struct Ctx { int tid, bid, nb; };

__device__ __forceinline__ u16 f2bf(float f) {
    unsigned u = __float_as_uint(f);
    u += 0x7fffu + ((u >> 16) & 1u);
    return (u16)(u >> 16);
}
__device__ __forceinline__ float bf2f(u16 b) { return __uint_as_float(((unsigned)b) << 16); }
__device__ __forceinline__ float wsum(float v) {
#pragma unroll
    for (int o = 32; o > 0; o >>= 1) v += __shfl_xor(v, o);
    return v;
}
__device__ __forceinline__ float wmax(float v) {
#pragma unroll
    for (int o = 32; o > 0; o >>= 1) v = fmaxf(v, __shfl_xor(v, o));
    return v;
}
typedef __bf16 bf16v2 __attribute__((ext_vector_type(2)));
typedef float f32v2 __attribute__((ext_vector_type(2)));
using u32x2 = __attribute__((ext_vector_type(2))) unsigned;
__device__ __forceinline__ unsigned pack2(float a, float b) {
    f32v2 v = {a, b};
    bf16v2 r = __builtin_convertvector(v, bf16v2);
    return __builtin_bit_cast(unsigned, r);
}
__device__ __forceinline__ float siluf(float x) { return x / (1.f + __expf(-x)); }
__device__ __forceinline__ float sigmf(float x) { return 1.f / (1.f + __expf(-x)); }
__device__ __forceinline__ float softplusf(float x) { return fmaxf(x, 0.f) + log1pf(expf(-fabsf(x))); }

constexpr int NT = 512, NW = 8;
constexpr int SMEM_BYTES = 131072 + 512;

__device__ __forceinline__ void convT_job(const Ctx& X, const float* __restrict__ src, int ld, int c0, int ncols, int K,
                                          u16* __restrict__ dst, int ldd, float* sm) {
    const int tilesN = ncols / 64, tilesK = K / 64;
    const int tid = X.tid;
    for (int t = X.bid; t < tilesN * tilesK; t += X.nb) {
        const int tk = t / tilesN, tn = t % tilesN;
        __syncthreads();
        for (int e = tid; e < 4096; e += NT) {
            int r = e >> 6, c = e & 63;
            sm[r * 65 + c] = src[(size_t)(tk * 64 + r) * ld + c0 + tn * 64 + c];
        }
        __syncthreads();
        for (int e = tid; e < 2048; e += NT) {
            int n = e >> 5, k2 = (e & 31) * 2;
            *(unsigned*)(dst + (size_t)(tn * 64 + n) * ldd + tk * 64 + k2) = pack2(sm[k2 * 65 + n], sm[(k2 + 1) * 65 + n]);
        }
    }
}

__device__ __forceinline__ void phase_prologue(const Ctx& X, const Params& p, char* smem) {
    const int bid = X.bid, nb = X.nb, tid = X.tid;
    float* sm = (float*)smem;
    char* ws = p.ws;
    for (int L = 0; L < 2; ++L) {
        char* wl = ws + OFF_W + L * W_LAYER;
        const float* win = p.w_in + (size_t)L * 1024 * IN_DIM;
        convT_job(X, win, IN_DIM, 0, 1280, 1024, (u16*)(wl + W_IN), 1024, sm);
        convT_job(X, win, IN_DIM, 1288, 5120, 1024, (u16*)(wl + W_IN) + (size_t)1280 * 1024, 1024, sm);
        convT_job(X, win, IN_DIM, 6408, 4096, 1024, (u16*)(wl + W_G), 1024, sm);
        for (int i = 0; i < 4; ++i)
            convT_job(X, p.w_branch + ((size_t)L * 4 + i) * 512 * 1024, 1024, 0, 1024, 512,
                      (u16*)(wl + W_B) + (size_t)i * 1024 * 512, 512, sm);
        convT_job(X, p.w_out + (size_t)L * 1024 * 1024, 1024, 0, 1024, 1024, (u16*)(wl + W_O), 1024, sm);
        convT_job(X, p.w_xq + (size_t)L * 1024 * 1024, 1024, 0, 1024, 1024, (u16*)(wl + W_XQ), 1024, sm);
        convT_job(X, p.w_xkv + (size_t)L * 1024 * 2048, 2048, 0, 2048, 1024, (u16*)(wl + W_XKV), 1024, sm);
        convT_job(X, p.w_xo + (size_t)L * 1024 * 1024, 1024, 0, 1024, 1024, (u16*)(wl + W_XO), 1024, sm);
        convT_job(X, p.w_pq + (size_t)L * 1024 * 2048, 2048, 0, 2048, 1024, (u16*)(wl + W_PQ), 1024, sm);
        float* wdt = (float*)(ws + OFF_WDT) + L * 8 * 1024;
        for (int e = bid * NT + tid; e < 8 * 1024; e += nb * NT) {
            int j = e >> 10, k = e & 1023;
            wdt[e] = win[(size_t)k * IN_DIM + 1280 + j];
        }
    }
    float* rope = (float*)(ws + OFF_ROPE);
    for (int e = bid * NT + tid; e < 2048 * 32; e += nb * NT) {
        int pos = e >> 5, i = e & 31;
        float inv = powf(10000.f, -(float)i / 32.f);
        float ang = (float)pos * inv;
        rope[e * 2] = cosf(ang);
        rope[e * 2 + 1] = sinf(ang);
    }
    {
        u16* kd = (u16*)(ws + OFF_KEYS);
        for (int e = bid * NT + tid; e < 2 * 8 * 2 * 128 * 128; e += nb * NT) kd[e] = f2bf(p.sub_keys[e]);
    }
    {
        const float4* xs = (const float4*)p.x;
        float4* hd = (float4*)(ws + OFF_H);
        for (size_t e = (size_t)bid * NT + tid; e < (size_t)T_ * 256; e += (size_t)nb * NT) hd[e] = xs[e];
        u16* mb = (u16*)(ws + OFF_MEMB);
        for (int e = bid * NT + tid; e < 2048 * 1024; e += nb * NT) mb[e] = f2bf(p.mem[e]);
    }
}

__device__ __forceinline__ void phase_norm(const Ctx& X, const Params& p, const float* __restrict__ gain, const float* __restrict__ wdt) {
    const int lane = X.tid & 63, wid = X.tid >> 6;
    const float* h = (const float*)(p.ws + OFF_H);
    u16* hn = (u16*)(p.ws + OFF_HN);
    float* dt = (float*)(p.ws + OFF_DT);
    for (int t = X.bid * NW + wid; t < T_; t += X.nb * NW) {
        const float4* hr = (const float4*)(h + (size_t)t * 1024);
        float4 v[4];
        float ss = 0.f;
#pragma unroll
        for (int i = 0; i < 4; ++i) {
            v[i] = hr[lane + i * 64];
            ss += v[i].x * v[i].x + v[i].y * v[i].y + v[i].z * v[i].z + v[i].w * v[i].w;
        }
        ss = wsum(ss);
        const float r = rsqrtf(ss * (1.f / 1024.f) + 1e-6f);
#pragma unroll
        for (int i = 0; i < 4; ++i) {
            float4 g = ((const float4*)gain)[lane + i * 64];
            v[i].x *= r * g.x; v[i].y *= r * g.y; v[i].z *= r * g.z; v[i].w *= r * g.w;
            u32x2 o;
            o[0] = pack2(v[i].x, v[i].y); o[1] = pack2(v[i].z, v[i].w);
            ((u32x2*)(hn + (size_t)t * 1024))[lane + i * 64] = o;
        }
        if (wdt) {
#pragma unroll
            for (int j = 0; j < 8; ++j) {
                float a = 0.f;
#pragma unroll
                for (int i = 0; i < 4; ++i) {
                    float4 w = ((const float4*)(wdt + j * 1024))[lane + i * 64];
                    a += v[i].x * w.x + v[i].y * w.y + v[i].z * w.z + v[i].w * w.w;
                }
                a = wsum(a);
                if (lane == 0) dt[t * 8 + j] = a;
            }
        }
    }
}

__device__ __forceinline__ void phase_final(const Ctx& X, const Params& p) {
    const int lane = X.tid & 63, wid = X.tid >> 6;
    const float* h = (const float*)(p.ws + OFF_H);
    for (int t = X.bid * NW + wid; t < T_; t += X.nb * NW) {
        const float4* hr = (const float4*)(h + (size_t)t * 1024);
        float4 v[4];
        float ss = 0.f;
#pragma unroll
        for (int i = 0; i < 4; ++i) {
            v[i] = hr[lane + i * 64];
            ss += v[i].x * v[i].x + v[i].y * v[i].y + v[i].z * v[i].z + v[i].w * v[i].w;
        }
        ss = wsum(ss);
        const float r = rsqrtf(ss * (1.f / 1024.f) + 1e-6f);
#pragma unroll
        for (int i = 0; i < 4; ++i) {
            float4 g = ((const float4*)p.final_norm)[lane + i * 64];
            float4 o;
            o.x = v[i].x * r * g.x; o.y = v[i].y * r * g.y; o.z = v[i].z * r * g.z; o.w = v[i].w * r * g.w;
            ((float4*)(p.out + (size_t)t * 1024))[lane + i * 64] = o;
        }
    }
}

typedef __attribute__((address_space(3))) unsigned lds_u32;
template <int BM, int BN>
__device__ __forceinline__ void gemm_core(const Ctx& X, const u16* __restrict__ Ag, int lda, const u16* __restrict__ Bg, int ldb,
                                          int K, f32x4 (&acc)[BM / 32][BN / 64], char* smem) {
    constexpr int NA = BM / 32, NB = BN / 64;
    constexpr int SA = BM / 64, SB = BN / 64;
    constexpr int ABYTES = BM * 128, STAGE = (BM + BN) * 128;
    const int tid = X.tid, lane = tid & 63, wid = tid >> 6;
    const int wr = wid >> 2, wc = wid & 3, fr = lane & 15, fq = lane >> 4;
    const int srow = tid >> 3, sslot = ((tid & 7) ^ (srow & 7)) * 8;
    const unsigned offA = (unsigned)(srow * lda + sslot), offB = (unsigned)(srow * ldb + sslot);
#define GSTAGE(buf, k0)                                                                                               \
    {                                                                                                                 \
        char* dA = smem + (buf) * STAGE + tid * 16;                                                                   \
        _Pragma("unroll") for (int i = 0; i < SA; ++i)                                                                \
            __builtin_amdgcn_global_load_lds((const unsigned*)(Ag + (offA + (unsigned)(64 * i * lda + (k0)))),        \
                                             (lds_u32*)(dA + i * 8192), 16, 0, 0);                                    \
        _Pragma("unroll") for (int i = 0; i < SB; ++i)                                                                \
            __builtin_amdgcn_global_load_lds((const unsigned*)(Bg + (offB + (unsigned)(64 * i * ldb + (k0)))),        \
                                             (lds_u32*)(dA + ABYTES + i * 8192), 16, 0, 0);                           \
    }
    GSTAGE(0, 0)
    const int nk = K >> 6;
    for (int kt = 0; kt < nk; ++kt) {
        __syncthreads();
        if (kt + 1 < nk) GSTAGE((kt + 1) & 1, (kt + 1) * 64)
        const char* bA = smem + (kt & 1) * STAGE;
        const char* bB = bA + ABYTES;
#pragma unroll
        for (int ks = 0; ks < 2; ++ks) {
            const int sw = ((ks * 4 + fq) ^ (fr & 7)) << 4;
            bf16x8 af[NA], bfr[NB];
#pragma unroll
            for (int m = 0; m < NA; ++m) af[m] = *(const bf16x8*)(bA + (wr * (BM / 2) + m * 16 + fr) * 128 + sw);
#pragma unroll
            for (int n = 0; n < NB; ++n) bfr[n] = *(const bf16x8*)(bB + (wc * (BN / 4) + n * 16 + fr) * 128 + sw);
#pragma unroll
            for (int m = 0; m < NA; ++m)
#pragma unroll
                for (int n = 0; n < NB; ++n)
                    acc[m][n] = __builtin_amdgcn_mfma_f32_16x16x32_bf16(bfr[n], af[m], acc[m][n], 0, 0, 0);
        }
    }
#undef GSTAGE
}

enum { EPI_PROJ = 0, EPI_BF16 = 1, EPI_RESID = 2 };

template <int EPI>
__device__ __forceinline__ void phase_gemm(const Ctx& X, const Params& p, const u16* __restrict__ A, int lda, const u16* __restrict__ Bt, int M,
                           int N, int K, void* Cout, int ldc, char* smem) {
    const int nM = M / 256, nN = N / 256;
    const int tid = X.tid, lane = tid & 63, wid = tid >> 6;
    const int wr = wid >> 2, wc = wid & 3, fr = lane & 15, fq = lane >> 4;
    const float* rope = (const float*)(p.ws + OFF_ROPE);
    for (int tile = X.bid; tile < nM * nN; tile += X.nb) {
        const int tm = tile % nM, tn = tile / nM;
        f32x4 acc[8][4];
#pragma unroll
        for (int m = 0; m < 8; ++m)
#pragma unroll
            for (int n = 0; n < 4; ++n) acc[m][n] = f32x4{0.f, 0.f, 0.f, 0.f};
        gemm_core<256, 256>(X, A + (size_t)tm * 256 * lda, lda, Bt + (size_t)tn * 256 * K, K, K, acc, smem);
        const int row0 = tm * 256 + wr * 128 + fr, col0 = tn * 256 + wc * 64 + 4 * fq;
        if (EPI == EPI_PROJ) {
            u16* C = (u16*)Cout;
            const int cw = tn * 256 + wc * 64;
            int mode = 0;
            if ((cw >= C_RQ && cw < C_RK) || (cw >= C_MQ && cw < C_MV) || (cw >= C_DQ && cw < C_DV)) mode = 1;
            if (cw >= C_RK && cw < C_RV) mode = 2;
            if (mode == 0) {
#pragma unroll
                for (int m = 0; m < 8; ++m)
#pragma unroll
                    for (int n = 0; n < 4; ++n) {
                        u32x2 o;
                        o[0] = pack2(acc[m][n][0], acc[m][n][1]);
                        o[1] = pack2(acc[m][n][2], acc[m][n][3]);
                        *(u32x2*)(C + (size_t)(row0 + m * 16) * ldc + col0 + n * 16) = o;
                    }
            } else {
                const float sc = (mode == 2) ? 0.125f : 1.f;
#pragma unroll
                for (int m = 0; m < 8; ++m) {
                    const int row = row0 + m * 16;
                    const int pos = row & (S_ - 1);
#pragma unroll
                    for (int n = 0; n < 2; ++n) {
                        const int d = n * 16 + 4 * fq;
                        const float4 cs0 = *(const float4*)(rope + ((size_t)pos * 32 + d) * 2);
                        const float4 cs1 = *(const float4*)(rope + ((size_t)pos * 32 + d + 2) * 2);
                        const f32x4 t1 = acc[m][n], t2 = acc[m][n + 2];
                        u32x2 o1, o2;
                        o1[0] = pack2((t1[0] * cs0.x - t2[0] * cs0.y) * sc, (t1[1] * cs0.z - t2[1] * cs0.w) * sc);
                        o1[1] = pack2((t1[2] * cs1.x - t2[2] * cs1.y) * sc, (t1[3] * cs1.z - t2[3] * cs1.w) * sc);
                        o2[0] = pack2((t2[0] * cs0.x + t1[0] * cs0.y) * sc, (t2[1] * cs0.z + t1[1] * cs0.w) * sc);
                        o2[1] = pack2((t2[2] * cs1.x + t1[2] * cs1.y) * sc, (t2[3] * cs1.z + t1[3] * cs1.w) * sc);
                        *(u32x2*)(C + (size_t)row * ldc + cw + d) = o1;
                        *(u32x2*)(C + (size_t)row * ldc + cw + d + 32) = o2;
                    }
                }
            }
        } else if (EPI == EPI_BF16) {
            u16* C = (u16*)Cout;
#pragma unroll
            for (int m = 0; m < 8; ++m)
#pragma unroll
                for (int n = 0; n < 4; ++n) {
                    u32x2 o;
                    o[0] = pack2(acc[m][n][0], acc[m][n][1]);
                    o[1] = pack2(acc[m][n][2], acc[m][n][3]);
                    *(u32x2*)(C + (size_t)(row0 + m * 16) * ldc + col0 + n * 16) = o;
                }
        } else {
            float* C = (float*)Cout;
#pragma unroll
            for (int m = 0; m < 8; ++m)
#pragma unroll
                for (int n = 0; n < 4; ++n) {
                    f32x4* q = (f32x4*)(C + (size_t)(row0 + m * 16) * ldc + col0 + n * 16);
                    *q = *q + acc[m][n];
                }
        }
    }
}

__device__ __forceinline__ void phase_merge(const Ctx& X, const Params& p, int L, char* smem) {
    const char* wl = p.ws + OFF_W + L * W_LAYER;
    const u16* hn = (const u16*)(p.ws + OFF_HN);
    const u16* ys = (const u16*)(p.ws + OFF_YS);
    u16* merged = (u16*)(p.ws + OFF_MERGED);
    const int nM = T_ / 128, nN = 1024 / 128;
    const int tid = X.tid, lane = tid & 63, wid = tid >> 6;
    const int wr = wid >> 2, wc = wid & 3, fr = lane & 15, fq = lane >> 4;
    for (int tile = X.bid; tile < nM * nN; tile += X.nb) {
        const int tm = tile % nM, tn = tile / nM;
        f32x4 accm[4][2];
#pragma unroll
        for (int m = 0; m < 4; ++m)
#pragma unroll
            for (int n = 0; n < 2; ++n) accm[m][n] = f32x4{0.f, 0.f, 0.f, 0.f};
        for (int i = 0; i < 4; ++i) {
            f32x4 accg[4][2], accb[4][2];
#pragma unroll
            for (int m = 0; m < 4; ++m)
#pragma unroll
                for (int n = 0; n < 2; ++n) {
                    accg[m][n] = f32x4{0.f, 0.f, 0.f, 0.f};
                    accb[m][n] = f32x4{0.f, 0.f, 0.f, 0.f};
                }
            gemm_core<128, 128>(X, hn + (size_t)tm * 128 * 1024, 1024,
                                (const u16*)(wl + W_G) + (size_t)(i * 1024 + tn * 128) * 1024, 1024, 1024, accg, smem);
            gemm_core<128, 128>(X, ys + ((size_t)i * T_ + (size_t)tm * 128) * 512, 512,
                                (const u16*)(wl + W_B) + ((size_t)i * 1024 + tn * 128) * 512, 512, 512, accb, smem);
#pragma unroll
            for (int m = 0; m < 4; ++m)
#pragma unroll
                for (int n = 0; n < 2; ++n)
#pragma unroll
                    for (int j = 0; j < 4; ++j) accm[m][n][j] += sigmf(accg[m][n][j]) * accb[m][n][j];
        }
        const int row0 = tm * 128 + wr * 64 + fr, col0 = tn * 128 + wc * 32 + 4 * fq;
#pragma unroll
        for (int m = 0; m < 4; ++m)
#pragma unroll
            for (int n = 0; n < 2; ++n) {
                u32x2 o;
                o[0] = pack2(accm[m][n][0], accm[m][n][1]);
                o[1] = pack2(accm[m][n][2], accm[m][n][3]);
                *(u32x2*)(merged + (size_t)(row0 + m * 16) * 1024 + col0 + n * 16) = o;
            }
    }
}

__device__ __forceinline__ void phase_kmean(const Ctx& X, const Params& p) {
    const u16* proj = (const u16*)(p.ws + OFF_PROJ);
    float* km = (float*)(p.ws + OFF_KMEAN);
    for (int e = X.bid * NT + X.tid; e < 8 * 8 * 8 * 64; e += X.nb * NT) {
        const int d = e & 63, n = (e >> 6) & 7, h = (e >> 9) & 7, b = e >> 12;
        float a = 0.f;
        const u16* kp = proj + ((size_t)b * S_ + n * 256) * NPROJ + C_MK + h * 64 + d;
        for (int j = 0; j < 256; ++j) a += bf2f(kp[(size_t)j * NPROJ]);
        km[e] = a * (1.f / 256.f);
    }
}

using s16x4 = __attribute__((ext_vector_type(4))) short;
typedef __attribute__((address_space(3))) s16x4 lds_s16x4;
__device__ __forceinline__ bf16x8 tr_pair(const u16* sV, int row_lo, int row_hi, int col, int pitch, int li) {
    const u16* a0 = sV + (row_lo + (li >> 2)) * pitch + col + (li & 3) * 4;
    const u16* a1 = sV + (row_hi + (li >> 2)) * pitch + col + (li & 3) * 4;
    s16x4 lo = __builtin_amdgcn_ds_read_tr16_b64_v4i16((lds_s16x4*)a0);
    s16x4 hi = __builtin_amdgcn_ds_read_tr16_b64_v4i16((lds_s16x4*)a1);
    bf16x8 r;
    r[0] = lo[0]; r[1] = lo[1]; r[2] = lo[2]; r[3] = lo[3];
    r[4] = hi[0]; r[5] = hi[1]; r[6] = hi[2]; r[7] = hi[3];
    return r;
}
template <int NB>
struct FlashStateT {
    float m, l;
    f32x4 o[NB];
};
typedef FlashStateT<4> FlashState;
template <int NB>
__device__ __forceinline__ void flash_update(f32x4 (&st)[4], FlashStateT<NB>& fs, const u16* sV, int pitch, int li, int g) {
    float mx = -1e30f;
#pragma unroll
    for (int kb = 0; kb < 4; ++kb)
#pragma unroll
        for (int j = 0; j < 4; ++j) mx = fmaxf(mx, st[kb][j]);
    mx = fmaxf(mx, __shfl_xor(mx, 16));
    mx = fmaxf(mx, __shfl_xor(mx, 32));
    const float mnew = fmaxf(fs.m, mx);
    const float alpha = __expf(fs.m - mnew);
    float rs = 0.f;
#pragma unroll
    for (int kb = 0; kb < 4; ++kb)
#pragma unroll
        for (int j = 0; j < 4; ++j) {
            const float pv = (st[kb][j] > -1e29f) ? __expf(st[kb][j] - mnew) : 0.f;
            st[kb][j] = pv;
            rs += pv;
        }
    rs += __shfl_xor(rs, 16);
    rs += __shfl_xor(rs, 32);
    fs.l = fs.l * alpha + rs;
    fs.m = mnew;
#pragma unroll
    for (int j = 0; j < 4; ++j) {
        const float aj = __shfl(alpha, 4 * g + j);
#pragma unroll
        for (int nb = 0; nb < NB; ++nb) fs.o[nb][j] *= aj;
    }
#pragma unroll
    for (int c = 0; c < 2; ++c) {
        union { bf16x8 v; unsigned u[4]; } pa;
        pa.u[0] = pack2(st[2 * c][0], st[2 * c][1]);
        pa.u[1] = pack2(st[2 * c][2], st[2 * c][3]);
        pa.u[2] = pack2(st[2 * c + 1][0], st[2 * c + 1][1]);
        pa.u[3] = pack2(st[2 * c + 1][2], st[2 * c + 1][3]);
#pragma unroll
        for (int nb = 0; nb < NB; ++nb) {
            const bf16x8 bv = tr_pair(sV, 2 * c * 16 + 4 * g, (2 * c + 1) * 16 + 4 * g, nb * 16, pitch, li);
            fs.o[nb] = __builtin_amdgcn_mfma_f32_16x16x32_bf16(pa.v, bv, fs.o[nb], 0, 0, 0);
        }
    }
}

__device__ __forceinline__ void phase_moba(const Ctx& X, const Params& p, char* smem) {
    const int tid = X.tid, lane = tid & 63, w = tid >> 6, li = lane & 15, g = lane >> 4;
    u16* sK = (u16*)smem;
    u16* sV = sK + 64 * 72;
    float* sKm = (float*)(smem + 18432);
    int* sMask = (int*)(smem + 20480);
    const u16* proj = (const u16*)(p.ws + OFF_PROJ);
    const float* km = (const float*)(p.ws + OFF_KMEAN);
    u16* ys = (u16*)(p.ws + OFF_YS) + (size_t)2 * T_ * 512;
    for (int it = X.bid; it < 1024; it += X.nb) {
        const int qt = 15 - (it >> 6);
        const int bh = it & 63, b = bh >> 3, h = bh & 7;
        const int q0 = qt * 128, nq = q0 >> 8;
        const u16* base = proj + (size_t)b * S_ * NPROJ;
        __syncthreads();
        sKm[tid] = km[(size_t)(b * 8 + h) * 512 + tid];
        if (tid == 0) *sMask = 0;
        const int qrow = q0 + 16 * w + li;
        bf16x8 qf[2];
#pragma unroll
        for (int ks = 0; ks < 2; ++ks)
            qf[ks] = *(const bf16x8*)(base + (size_t)qrow * NPROJ + C_MQ + h * 64 + ks * 32 + g * 8);
        __syncthreads();
        int selmask = 0;
        if (nq > 0) {
            float gt[8];
#pragma unroll
            for (int n = 0; n < 8; ++n) {
                float a = 0.f;
#pragma unroll
                for (int ks = 0; ks < 2; ++ks)
#pragma unroll
                    for (int j = 0; j < 8; ++j) a += bf2f((u16)qf[ks][j]) * sKm[n * 64 + ks * 32 + g * 8 + j];
                a += __shfl_xor(a, 16);
                a += __shfl_xor(a, 32);
                gt[n] = (n < nq) ? a : -INFINITY;
            }
#pragma unroll
            for (int r = 0; r < 3; ++r) {
                int bi = -1;
                float bv = -INFINITY;
#pragma unroll
                for (int n = 0; n < 8; ++n)
                    if (gt[n] > bv) { bv = gt[n]; bi = n; }
                if (bi >= 0) {
                    selmask |= 1 << bi;
#pragma unroll
                    for (int n = 0; n < 8; ++n)
                        if (n == bi) gt[n] = -INFINITY;
                }
            }
            if (selmask) atomicOr(sMask, selmask);
        }
        __syncthreads();
        const int bmask = *sMask;
        FlashState fs;
        fs.m = -1e30f; fs.l = 0.f;
#pragma unroll
        for (int nb = 0; nb < 4; ++nb) fs.o[nb] = f32x4{0.f, 0.f, 0.f, 0.f};
        const int nPast = nq * 4, nOwn = ((q0 + 127 - nq * 256) >> 6) + 1;
        for (int t = 0; t < nPast + nOwn; ++t) {
            int k0, nblk = 0;
            const bool past = t < nPast;
            if (past) {
                nblk = t >> 2;
                if (!((bmask >> nblk) & 1)) continue;
                k0 = nblk * 256 + (t & 3) * 64;
            } else {
                k0 = nq * 256 + (t - nPast) * 64;
            }
            __syncthreads();
            {
                const int r = tid >> 3, c8 = (tid & 7) * 8;
                *(u32x4*)(sK + r * 72 + c8) = *(const u32x4*)(base + (size_t)(k0 + r) * NPROJ + C_MK + h * 64 + c8);
                *(u32x4*)(sV + r * 72 + c8) = *(const u32x4*)(base + (size_t)(k0 + r) * NPROJ + C_MV + h * 64 + c8);
            }
            __syncthreads();
            if (!past && k0 > q0 + 16 * w + 15) continue;
            f32x4 st[4];
#pragma unroll
            for (int kb = 0; kb < 4; ++kb) {
                st[kb] = f32x4{0.f, 0.f, 0.f, 0.f};
#pragma unroll
                for (int ks = 0; ks < 2; ++ks) {
                    const bf16x8 a = *(const bf16x8*)(sK + (kb * 16 + li) * 72 + ks * 32 + g * 8);
                    st[kb] = __builtin_amdgcn_mfma_f32_16x16x32_bf16(a, qf[ks], st[kb], 0, 0, 0);
                }
            }
            const bool lane_ok = past ? (((selmask >> nblk) & 1) != 0) : true;
#pragma unroll
            for (int kb = 0; kb < 4; ++kb)
#pragma unroll
                for (int j = 0; j < 4; ++j) {
                    const int key = k0 + kb * 16 + 4 * g + j;
                    const bool valid = lane_ok && (past || key <= qrow);
                    st[kb][j] = valid ? st[kb][j] * 0.125f : -1e30f;
                }
            flash_update<4>(st, fs, sV, 72, li, g);
        }
#pragma unroll
        for (int j = 0; j < 4; ++j) {
            const float inv = 1.f / __shfl(fs.l, 4 * g + j);
            const int row = q0 + 16 * w + 4 * g + j;
#pragma unroll
            for (int nb = 0; nb < 4; ++nb)
                ys[((size_t)b * S_ + row) * 512 + h * 64 + nb * 16 + li] = f2bf(fs.o[nb][j] * inv);
        }
    }
}

__device__ __forceinline__ void phase_dil(const Ctx& X, const Params& p, char* smem) {
    const int tid = X.tid, lane = tid & 63, w = tid >> 6, li = lane & 15, g = lane >> 4;
    u16* sV = (u16*)smem + w * (64 * 72);
    const u16* proj = (const u16*)(p.ws + OFF_PROJ);
    u16* ys = (u16*)(p.ws + OFF_YS) + (size_t)3 * T_ * 512;
    for (int it = X.bid; it < 1024; it += X.nb) {
        const int wi = it * 8 + w;
        const int u0 = (wi & 7) * 16, r16 = (wi >> 3) & 15, h = (wi >> 7) & 7, b = wi >> 10;
        const u16* base = proj + (size_t)b * S_ * NPROJ;
        const int iq = r16 + 16 * (u0 + li);
        bf16x8 qf[2];
#pragma unroll
        for (int ks = 0; ks < 2; ++ks)
            qf[ks] = *(const bf16x8*)(base + (size_t)iq * NPROJ + C_DQ + h * 64 + ks * 32 + g * 8);
        FlashState fs;
        fs.m = -1e30f; fs.l = 0.f;
#pragma unroll
        for (int nb = 0; nb < 4; ++nb) fs.o[nb] = f32x4{0.f, 0.f, 0.f, 0.f};
        for (int t = 0; t < 12; ++t) {
            int dl, tt;
            if (t < 3) { dl = 16; tt = t; } else if (t < 6) { dl = 4; tt = t - 3; } else { dl = 1; tt = t - 6; }
            const int res = r16 & (dl - 1), a = r16 / dl, sq = 16 / dl;
            const int uq = a + sq * (u0 + li);
            const int uq0 = a + sq * u0;
            const int kt0 = uq0 - 128 + 64 * tt;
            const bool active = (kt0 + 63 >= 0);
            __syncthreads();
            if (active) {
#pragma unroll
                for (int i = 0; i < 8; ++i) {
                    const int ch = lane + i * 64, r = ch >> 3, c8 = (ch & 7) * 8;
                    int uk = kt0 + r;
                    uk = uk < 0 ? 0 : uk;
                    int tok = res + dl * uk;
                    tok = tok > S_ - 1 ? S_ - 1 : tok;
                    *(u32x4*)(sV + r * 72 + c8) = *(const u32x4*)(base + (size_t)tok * NPROJ + C_DV + h * 64 + c8);
                }
            }
            __syncthreads();
            if (active) {
                f32x4 st[4];
#pragma unroll
                for (int kb = 0; kb < 4; ++kb) {
                    int uk = kt0 + kb * 16 + li;
                    uk = uk < 0 ? 0 : uk;
                    int tok = res + dl * uk;
                    tok = tok > S_ - 1 ? S_ - 1 : tok;
                    st[kb] = f32x4{0.f, 0.f, 0.f, 0.f};
#pragma unroll
                    for (int ks = 0; ks < 2; ++ks) {
                        const bf16x8 ka = *(const bf16x8*)(base + (size_t)tok * NPROJ + C_DK + h * 64 + ks * 32 + g * 8);
                        st[kb] = __builtin_amdgcn_mfma_f32_16x16x32_bf16(ka, qf[ks], st[kb], 0, 0, 0);
                    }
                }
#pragma unroll
                for (int kb = 0; kb < 4; ++kb)
#pragma unroll
                    for (int j = 0; j < 4; ++j) {
                        const int uk = kt0 + kb * 16 + 4 * g + j;
                        const int dist = uq - uk;
                        const bool valid = (uk >= 0) && (dist >= 0) && (dist <= 128);
                        st[kb][j] = valid ? st[kb][j] * 0.125f : -1e30f;
                    }
                flash_update<4>(st, fs, sV, 72, li, g);
            }
        }
#pragma unroll
        for (int j = 0; j < 4; ++j) {
            const float inv = 1.f / __shfl(fs.l, 4 * g + j);
            const int tok = r16 + 16 * (u0 + 4 * g + j);
#pragma unroll
            for (int nb = 0; nb < 4; ++nb)
                ys[((size_t)b * S_ + tok) * 512 + h * 64 + nb * 16 + li] = f2bf(fs.o[nb][j] * inv);
        }
    }
}


__device__ __forceinline__ void phase_premix(const Ctx& X, const Params& p, int L) {
    const u16* proj = (const u16*)(p.ws + OFF_PROJ);
    u16* cv = (u16*)(p.ws + OFF_CONV);
    const float* cw = p.conv_w + (size_t)L * 4 * 768;
    const float* cb = p.conv_b + (size_t)L * 768;
    for (int e = X.bid * NT + X.tid; e < T_ * 96; e += X.nb * NT) {
        const int t = e / 96, c8 = (e % 96) * 8, s = t & (S_ - 1);
        float acc[8];
#pragma unroll
        for (int i = 0; i < 8; ++i) acc[i] = cb[c8 + i];
#pragma unroll
        for (int k = 0; k < 4; ++k) {
            if (s - 3 + k >= 0) {
                const u32x4 v = *(const u32x4*)(proj + (size_t)(t - 3 + k) * NPROJ + C_XBC + c8);
#pragma unroll
                for (int i = 0; i < 4; ++i) {
                    acc[2 * i] += cw[k * 768 + c8 + 2 * i] * __uint_as_float(v[i] << 16);
                    acc[2 * i + 1] += cw[k * 768 + c8 + 2 * i + 1] * __uint_as_float(v[i] & 0xffff0000u);
                }
            }
        }
        u32x4 o;
#pragma unroll
        for (int i = 0; i < 4; ++i) o[i] = pack2(siluf(acc[2 * i]), siluf(acc[2 * i + 1]));
        *(u32x4*)(cv + (size_t)t * 768 + c8) = o;
    }
    const float* dtr = (const float*)(p.ws + OFF_DT);
    float* dtv = (float*)(p.ws + OFF_DTV);
    float* acv = (float*)(p.ws + OFF_ACUM);
    for (int e = X.bid * NT + X.tid; e < 8 * 32 * 8; e += X.nb * NT) {
        const int h = e & 7, ch = e >> 3;
        const float bias = p.dt_bias[L * 8 + h], A = -expf(p.a_log[L * 8 + h]);
        float ac = 0.f;
        for (int i = 0; i < 64; ++i) {
            const int t = ch * 64 + i;
            const float dt = softplusf(dtr[t * 8 + h] + bias);
            ac += dt * A;
            dtv[t * 8 + h] = dt;
            acv[t * 8 + h] = ac;
        }
    }
}

template <bool SSD>
__device__ __forceinline__ void linattn_item(const Ctx& X, const Params& p, int L, int b, int h, char* smem) {
    const int tid = X.tid & 255, lane = tid & 63, w = tid >> 6, li = lane & 15, g = lane >> 4;
    u16* sK = (u16*)smem;
    u16* sV = sK + 64 * 72;
    u16* sVd = sV + 64 * 72;
    u16* sSt = sVd + 64 * 72;
    float* sAc = (float*)(smem + 36864);
    const u16* proj = (const u16*)(p.ws + OFF_PROJ) + (size_t)b * S_ * NPROJ;
    const u16* cv = (const u16*)(p.ws + OFF_CONV) + (size_t)b * S_ * 768;
    const float* dtv = (const float*)(p.ws + OFF_DTV) + (size_t)b * S_ * 8;
    const float* acv = (const float*)(p.ws + OFF_ACUM) + (size_t)b * S_ * 8;
    const u16 *qsrc, *ksrc, *vsrc;
    int ld;
    if (SSD) { qsrc = cv + 640 + (h >> 2) * 64; ksrc = cv + 512 + (h >> 2) * 64; vsrc = cv + h * 64; ld = 768; }
    else { qsrc = proj + C_RQ + h * 64; ksrc = proj + C_RK + h * 64; vsrc = proj + C_RV + h * 64; ld = NPROJ; }
    const float lg = log2f(1.f - exp2f(-5.f - (float)h));
    float crs[4];
#pragma unroll
    for (int j = 0; j < 4; ++j) crs[j] = exp2f((float)(16 * w + 4 * g + j + 1) * lg);
    const float sdecR = exp2f(64.f * lg);
    const int r0 = tid >> 3, c8 = (tid & 7) * 8;
    const float vds0 = exp2f((float)(63 - r0) * lg), vds1 = exp2f((float)(31 - r0) * lg);
    f32x4 accs[4];
#pragma unroll
    for (int n = 0; n < 4; ++n) accs[n] = f32x4{0.f, 0.f, 0.f, 0.f};
    u32x4 rk[2], rv[2];
    bf16x8 qn[2];
#pragma unroll
    for (int i = 0; i < 2; ++i) {
        rk[i] = *(const u32x4*)(ksrc + (r0 + 32 * i) * ld + c8);
        rv[i] = *(const u32x4*)(vsrc + (r0 + 32 * i) * ld + c8);
    }
#pragma unroll
    for (int ks = 0; ks < 2; ++ks) qn[ks] = *(const bf16x8*)(qsrc + (16 * w + li) * ld + ks * 32 + g * 8);
    const float gainv0 = SSD ? 0.f : 0.f;
    (void)gainv0;
    for (int c = 0; c < 32; ++c) {
        const int t0 = c * 64;
        __syncthreads();
#pragma unroll
        for (int n = 0; n < 4; ++n)
#pragma unroll
            for (int j = 0; j < 4; ++j) sSt[(16 * w + 4 * g + j) * 72 + n * 16 + li] = f2bf(accs[n][j]);
        float aclast = 0.f;
        if (SSD) {
            aclast = acv[(t0 + 63) * 8 + h];
            if (tid < 64) sAc[tid] = acv[(t0 + tid) * 8 + h];
        }
#pragma unroll
        for (int i = 0; i < 2; ++i) {
            const int r = r0 + 32 * i;
            *(u32x4*)(sK + r * 72 + c8) = rk[i];
            float s1 = 1.f, s2;
            if (SSD) {
                s1 = dtv[(t0 + r) * 8 + h];
                s2 = s1 * __expf(aclast - acv[(t0 + r) * 8 + h]);
            } else {
                s2 = (i == 0) ? vds0 : vds1;
            }
            u32x4 o1, o2;
#pragma unroll
            for (int q = 0; q < 4; ++q) {
                const float lo = __uint_as_float(rv[i][q] << 16), hi = __uint_as_float(rv[i][q] & 0xffff0000u);
                o1[q] = SSD ? pack2(lo * s1, hi * s1) : rv[i][q];
                o2[q] = pack2(lo * s2, hi * s2);
            }
            *(u32x4*)(sV + r * 72 + c8) = o1;
            *(u32x4*)(sVd + r * 72 + c8) = o2;
        }
        __syncthreads();
        bf16x8 qf[2];
        qf[0] = qn[0]; qf[1] = qn[1];
        if (c + 1 < 32) {
#pragma unroll
            for (int i = 0; i < 2; ++i) {
                rk[i] = *(const u32x4*)(ksrc + (t0 + 64 + r0 + 32 * i) * ld + c8);
                rv[i] = *(const u32x4*)(vsrc + (t0 + 64 + r0 + 32 * i) * ld + c8);
            }
#pragma unroll
            for (int ks = 0; ks < 2; ++ks)
                qn[ks] = *(const bf16x8*)(qsrc + (t0 + 64 + 16 * w + li) * ld + ks * 32 + g * 8);
        }
        u16 e1[4][4], e2[4][4];
#pragma unroll
        for (int j = 0; j < 4; ++j) {
            const int row = t0 + 16 * w + 4 * g + j;
#pragma unroll
            for (int nb = 0; nb < 4; ++nb) {
                if (SSD) {
                    e1[nb][j] = cv[row * 768 + h * 64 + nb * 16 + li];
                    e2[nb][j] = proj[row * NPROJ + C_Z + h * 64 + nb * 16 + li];
                } else {
                    e1[nb][j] = proj[row * NPROJ + C_RG + h * 64 + nb * 16 + li];
                    e2[nb][j] = 0;
                }
            }
        }
        f32x4 st[4];
#pragma unroll
        for (int kb = 0; kb < 4; ++kb) {
            st[kb] = f32x4{0.f, 0.f, 0.f, 0.f};
            if (kb <= w) {
#pragma unroll
                for (int ks = 0; ks < 2; ++ks) {
                    const bf16x8 a = *(const bf16x8*)(sK + (kb * 16 + li) * 72 + ks * 32 + g * 8);
                    st[kb] = __builtin_amdgcn_mfma_f32_16x16x32_bf16(a, qf[ks], st[kb], 0, 0, 0);
                }
            }
        }
        if (SSD) {
            const float acl = sAc[16 * w + li];
#pragma unroll
            for (int kb = 0; kb < 4; ++kb) {
                const f32x4 acs = *(const f32x4*)(sAc + kb * 16 + 4 * g);
#pragma unroll
                for (int j = 0; j < 4; ++j) {
                    const int d = (16 * w + li) - (kb * 16 + 4 * g + j);
                    st[kb][j] = d >= 0 ? st[kb][j] * __expf(acl - acs[j]) : 0.f;
                }
            }
        } else {
#pragma unroll
            for (int kb = 0; kb < 4; ++kb)
#pragma unroll
                for (int j = 0; j < 4; ++j) {
                    const int d = (16 * w + li) - (kb * 16 + 4 * g + j);
                    st[kb][j] = d >= 0 ? st[kb][j] * exp2f((float)d * lg) : 0.f;
                }
        }
        f32x4 o[4], oc[4];
#pragma unroll
        for (int nb = 0; nb < 4; ++nb) { o[nb] = f32x4{0.f, 0.f, 0.f, 0.f}; oc[nb] = f32x4{0.f, 0.f, 0.f, 0.f}; }
#pragma unroll
        for (int cc = 0; cc < 2; ++cc) {
            union { bf16x8 v; unsigned u[4]; } pa;
            pa.u[0] = pack2(st[2 * cc][0], st[2 * cc][1]);
            pa.u[1] = pack2(st[2 * cc][2], st[2 * cc][3]);
            pa.u[2] = pack2(st[2 * cc + 1][0], st[2 * cc + 1][1]);
            pa.u[3] = pack2(st[2 * cc + 1][2], st[2 * cc + 1][3]);
#pragma unroll
            for (int nb = 0; nb < 4; ++nb) {
                const bf16x8 bv = tr_pair(sV, 2 * cc * 16 + 4 * g, (2 * cc + 1) * 16 + 4 * g, nb * 16, 72, li);
                o[nb] = __builtin_amdgcn_mfma_f32_16x16x32_bf16(pa.v, bv, o[nb], 0, 0, 0);
            }
        }
#pragma unroll
        for (int ks = 0; ks < 2; ++ks)
#pragma unroll
            for (int nb = 0; nb < 4; ++nb) {
                const bf16x8 sb = *(const bf16x8*)(sSt + (nb * 16 + li) * 72 + ks * 32 + g * 8);
                oc[nb] = __builtin_amdgcn_mfma_f32_16x16x32_bf16(qf[ks], sb, oc[nb], 0, 0, 0);
            }
        {
            f32x4 dl[4];
#pragma unroll
            for (int n = 0; n < 4; ++n) dl[n] = f32x4{0.f, 0.f, 0.f, 0.f};
#pragma unroll
            for (int ks = 0; ks < 2; ++ks) {
                const bf16x8 av = tr_pair(sVd, ks * 32 + 8 * g, ks * 32 + 8 * g + 4, 16 * w, 72, li);
#pragma unroll
                for (int n = 0; n < 4; ++n) {
                    const bf16x8 bk = tr_pair(sK, ks * 32 + 8 * g, ks * 32 + 8 * g + 4, n * 16, 72, li);
                    dl[n] = __builtin_amdgcn_mfma_f32_16x16x32_bf16(av, bk, dl[n], 0, 0, 0);
                }
            }
            const float sd = SSD ? __expf(aclast) : sdecR;
#pragma unroll
            for (int n = 0; n < 4; ++n)
#pragma unroll
                for (int j = 0; j < 4; ++j) accs[n][j] = accs[n][j] * sd + dl[n][j];
        }
        if (SSD) {
            u16* ys = (u16*)(p.ws + OFF_YS) + (size_t)b * S_ * 512;
            const float Dk = p.ssd_d[L * 8 + h];
#pragma unroll
            for (int j = 0; j < 4; ++j) {
                const int lq = 16 * w + 4 * g + j;
                const float ea = __expf(sAc[lq]);
#pragma unroll
                for (int nb = 0; nb < 4; ++nb) {
                    const float y = o[nb][j] + ea * oc[nb][j] + Dk * bf2f(e1[nb][j]);
                    ys[(t0 + lq) * 512 + h * 64 + nb * 16 + li] = f2bf(y * siluf(bf2f(e2[nb][j])));
                }
            }
        } else {
            u16* ys = (u16*)(p.ws + OFF_YS) + (size_t)1 * T_ * 512 + (size_t)b * S_ * 512;
#pragma unroll
            for (int j = 0; j < 4; ++j) {
                float yv[4], sm = 0.f;
#pragma unroll
                for (int nb = 0; nb < 4; ++nb) { yv[nb] = o[nb][j] + crs[j] * oc[nb][j]; sm += yv[nb]; }
                sm += __shfl_xor(sm, 1); sm += __shfl_xor(sm, 2); sm += __shfl_xor(sm, 4); sm += __shfl_xor(sm, 8);
                const float mu = sm * (1.f / 64.f);
                float vs = 0.f;
#pragma unroll
                for (int nb = 0; nb < 4; ++nb) { yv[nb] -= mu; vs += yv[nb] * yv[nb]; }
                vs += __shfl_xor(vs, 1); vs += __shfl_xor(vs, 2); vs += __shfl_xor(vs, 4); vs += __shfl_xor(vs, 8);
                const float rstd = rsqrtf(vs * (1.f / 64.f) + 1e-6f);
                const int lq = 16 * w + 4 * g + j;
#pragma unroll
                for (int nb = 0; nb < 4; ++nb) {
                    const float gn = p.ret_norm[L * 512 + h * 64 + nb * 16 + li];
                    ys[(t0 + lq) * 512 + h * 64 + nb * 16 + li] = f2bf(siluf(bf2f(e1[nb][j])) * yv[nb] * rstd * gn);
                }
            }
        }
    }
}

__device__ __forceinline__ void phase_mixers(const Ctx& X, const Params& p, int L, char* smem) {
    const int half = __builtin_amdgcn_readfirstlane(X.tid >> 8);
    for (int it2 = X.bid; it2 < 64; it2 += X.nb) {
        const int item = it2 * 2 + half;
        if (it2 < 32) linattn_item<true>(X, p, L, item >> 3, item & 7, smem + half * 37376);
        else linattn_item<false>(X, p, L, (item - 64) >> 3, item & 7, smem + half * 37376);
    }
    __syncthreads();
    phase_moba(X, p, smem);
    __syncthreads();
    phase_dil(X, p, smem);
}

__device__ __forceinline__ void phase_ssdnorm(const Ctx& X, const Params& p, int L) {
    const int lane = X.tid & 63, wid = X.tid >> 6;
    u16* ys = (u16*)(p.ws + OFF_YS);
    const float* gain = p.ssd_norm + L * 512;
    for (int t = X.bid * NW + wid; t < T_; t += X.nb * NW) {
        const u32x4 v = *(const u32x4*)(ys + (size_t)t * 512 + lane * 8);
        float f[8];
        float ss = 0.f;
#pragma unroll
        for (int i = 0; i < 4; ++i) {
            f[2 * i] = __uint_as_float(v[i] << 16);
            f[2 * i + 1] = __uint_as_float(v[i] & 0xffff0000u);
            ss += f[2 * i] * f[2 * i] + f[2 * i + 1] * f[2 * i + 1];
        }
        ss = wsum(ss);
        const float r = rsqrtf(ss * (1.f / 512.f) + 1e-6f);
        u32x4 o;
#pragma unroll
        for (int i = 0; i < 4; ++i)
            o[i] = pack2(f[2 * i] * r * gain[lane * 8 + 2 * i], f[2 * i + 1] * r * gain[lane * 8 + 2 * i + 1]);
        *(u32x4*)(ys + (size_t)t * 512 + lane * 8) = o;
    }
}

__device__ __forceinline__ void phase_xattn(const Ctx& X, const Params& p, int L, char* smem) {
    const int tid = X.tid, lane = tid & 63, w = tid >> 6, li = lane & 15, g = lane >> 4;
    u16* sV = (u16*)smem;
    const u16* xq = (const u16*)(p.ws + OFF_XQ);
    const u16* kv = (const u16*)(p.ws + OFF_XKV) + (size_t)L * 2048 * 2048;
    u16* xo = (u16*)(p.ws + OFF_XO);
    for (int it = X.bid; it < 512; it += X.nb) {
        const int qt = it & 15, hx = (it >> 4) & 3, b = it >> 6;
        const size_t qrow = (size_t)b * S_ + qt * 128 + 16 * w + li;
        bf16x8 qf[8];
#pragma unroll
        for (int ks = 0; ks < 8; ++ks) qf[ks] = *(const bf16x8*)(xq + qrow * 1024 + hx * 256 + ks * 32 + g * 8);
        FlashStateT<16> fs;
        fs.m = -1e30f; fs.l = 0.f;
#pragma unroll
        for (int nb = 0; nb < 16; ++nb) fs.o[nb] = f32x4{0.f, 0.f, 0.f, 0.f};
        const u16* kbase = kv + (size_t)b * 256 * 2048 + hx * 256;
        const u16* vbase = kbase + 1024;
        for (int kt = 0; kt < 4; ++kt) {
            __syncthreads();
#pragma unroll
            for (int i = 0; i < 4; ++i) {
                const int ch = tid + i * NT, r = ch >> 5, c8 = (ch & 31) * 8;
                *(u32x4*)(sV + r * 264 + c8) = *(const u32x4*)(vbase + (size_t)(kt * 64 + r) * 2048 + c8);
            }
            __syncthreads();
            f32x4 st[4];
#pragma unroll
            for (int kb = 0; kb < 4; ++kb) {
                st[kb] = f32x4{0.f, 0.f, 0.f, 0.f};
#pragma unroll
                for (int ks = 0; ks < 8; ++ks) {
                    const bf16x8 a = *(const bf16x8*)(kbase + (size_t)(kt * 64 + kb * 16 + li) * 2048 + ks * 32 + g * 8);
                    st[kb] = __builtin_amdgcn_mfma_f32_16x16x32_bf16(a, qf[ks], st[kb], 0, 0, 0);
                }
#pragma unroll
                for (int j = 0; j < 4; ++j) st[kb][j] *= 0.0625f;
            }
            flash_update<16>(st, fs, sV, 264, li, g);
        }
#pragma unroll
        for (int j = 0; j < 4; ++j) {
            const float inv = 1.f / __shfl(fs.l, 4 * g + j);
            const size_t row = (size_t)b * S_ + qt * 128 + 16 * w + 4 * g + j;
#pragma unroll
            for (int nb = 0; nb < 16; ++nb) xo[row * 1024 + hx * 256 + nb * 16 + li] = f2bf(fs.o[nb][j] * inv);
        }
    }
}

__device__ __forceinline__ void phase_peer_select(const Ctx& X, const Params& p, int L) {
    const int tid = X.tid, lane = tid & 63, w = tid >> 6, li = lane & 15, g = lane >> 4;
    const u16* pq = (const u16*)(p.ws + OFF_PQ);
    int* seli = (int*)(p.ws + OFF_SELI);
    float* selg = (float*)(p.ws + OFF_SELG);
    const u16* keys = (const u16*)(p.ws + OFF_KEYS) + (size_t)L * 8 * 2 * 128 * 128;
    for (int it = X.bid; it < 128 * 8; it += X.nb) {
        const int hh = it & 7, t0 = (it >> 3) * 128 + 16 * w;
        float tv0[16], tv1[16];
        unsigned ti0[4] = {0u, 0u, 0u, 0u}, ti1[4] = {0u, 0u, 0u, 0u};
#pragma unroll
        for (int pp = 0; pp < 2; ++pp) {
            bf16x8 qf[4];
#pragma unroll
            for (int ks = 0; ks < 4; ++ks)
                qf[ks] = *(const bf16x8*)(pq + (size_t)(t0 + li) * 2048 + hh * 256 + pp * 128 + ks * 32 + g * 8);
            const u16* kbase = keys + (size_t)(hh * 2 + pp) * 128 * 128;
            f32x4 sc[8];
#pragma unroll
            for (int kb = 0; kb < 8; ++kb) {
                sc[kb] = f32x4{0.f, 0.f, 0.f, 0.f};
#pragma unroll
                for (int ks = 0; ks < 4; ++ks) {
                    const bf16x8 a = *(const bf16x8*)(kbase + (kb * 16 + li) * 128 + ks * 32 + g * 8);
                    sc[kb] = __builtin_amdgcn_mfma_f32_16x16x32_bf16(a, qf[ks], sc[kb], 0, 0, 0);
                }
            }
#pragma unroll
            for (int r = 0; r < 16; ++r) {
                float bv = -INFINITY;
                int bk = 0x7fffffff;
#pragma unroll
                for (int kb = 0; kb < 8; ++kb)
#pragma unroll
                    for (int j = 0; j < 4; ++j) {
                        const bool gt = sc[kb][j] > bv;
                        bv = gt ? sc[kb][j] : bv;
                        bk = gt ? (kb * 16 + 4 * g + j) : bk;
                    }
#pragma unroll
                for (int o = 16; o <= 32; o <<= 1) {
                    const float ov = __shfl_xor(bv, o);
                    const int ok = __shfl_xor(bk, o);
                    const bool tk = (ov > bv) || (ov == bv && ok < bk);
                    bv = tk ? ov : bv;
                    bk = tk ? ok : bk;
                }
                if (pp == 0) { tv0[r] = bv; ti0[r >> 2] |= (unsigned)bk << (8 * (r & 3)); }
                else { tv1[r] = bv; ti1[r >> 2] |= (unsigned)bk << (8 * (r & 3)); }
#pragma unroll
                for (int kb = 0; kb < 8; ++kb)
#pragma unroll
                    for (int j = 0; j < 4; ++j) sc[kb][j] = (kb * 16 + 4 * g + j == bk) ? -INFINITY : sc[kb][j];
            }
        }
        float cs0[16], cs1[3], cs2, cs3;
        {
            const float sa0 = (g == 0) ? tv0[0] : (g == 1) ? tv0[1] : (g == 2) ? tv0[2] : tv0[3];
            const float sa1 = (g == 0) ? tv0[4] : (g == 1) ? tv0[5] : (g == 2) ? tv0[6] : tv0[7];
            const float sa2 = (g == 0) ? tv0[8] : (g == 1) ? tv0[9] : (g == 2) ? tv0[10] : tv0[11];
            const float sa3 = (g == 0) ? tv0[12] : (g == 1) ? tv0[13] : (g == 2) ? tv0[14] : tv0[15];
#pragma unroll
            for (int bq = 0; bq < 16; ++bq) cs0[bq] = sa0 + tv1[bq];
#pragma unroll
            for (int bq = 0; bq < 3; ++bq) cs1[bq] = sa1 + tv1[bq];
            cs2 = sa2 + tv1[0];
            cs3 = sa3 + tv1[0];
        }
        float bs[16];
        unsigned bc[4] = {0u, 0u, 0u, 0u};
#pragma unroll
        for (int r = 0; r < 16; ++r) {
            float bv = -INFINITY;
            int bk = 0x7fffffff;
#define CAND(v, c) { const bool gt = (v) > bv; bv = gt ? (v) : bv; bk = gt ? (c) : bk; }
#pragma unroll
            for (int bq = 0; bq < 16; ++bq) CAND(cs0[bq], g * 16 + bq)
#pragma unroll
            for (int bq = 0; bq < 3; ++bq) CAND(cs1[bq], (g + 4) * 16 + bq)
            CAND(cs2, (g + 8) * 16)
            CAND(cs3, (g + 12) * 16)
#undef CAND
#pragma unroll
            for (int o = 16; o <= 32; o <<= 1) {
                const float ov = __shfl_xor(bv, o);
                const int ok = __shfl_xor(bk, o);
                const bool tk = (ov > bv) || (ov == bv && ok < bk);
                bv = tk ? ov : bv;
                bk = tk ? ok : bk;
            }
            bs[r] = bv;
            bc[r >> 2] |= (unsigned)bk << (8 * (r & 3));
#pragma unroll
            for (int bq = 0; bq < 16; ++bq) cs0[bq] = (g * 16 + bq == bk) ? -INFINITY : cs0[bq];
#pragma unroll
            for (int bq = 0; bq < 3; ++bq) cs1[bq] = ((g + 4) * 16 + bq == bk) ? -INFINITY : cs1[bq];
            cs2 = ((g + 8) * 16 == bk) ? -INFINITY : cs2;
            cs3 = ((g + 12) * 16 == bk) ? -INFINITY : cs3;
        }
        float es = 0.f;
#pragma unroll
        for (int r = 0; r < 16; ++r) es += __expf(bs[r] - bs[0]);
        const float inv = 1.f / es;
        int oi[4];
        float og[4];
        const unsigned bcw = (g == 0) ? bc[0] : (g == 1) ? bc[1] : (g == 2) ? bc[2] : bc[3];
#pragma unroll
        for (int q = 0; q < 4; ++q) {
            const int c = (bcw >> (8 * q)) & 255;
            const float bsv = (g == 0) ? bs[q] : (g == 1) ? bs[4 + q] : (g == 2) ? bs[8 + q] : bs[12 + q];
            const int a = c >> 4, bq = c & 15;
            const unsigned wa = ((a >> 2) == 0) ? ti0[0] : ((a >> 2) == 1) ? ti0[1] : ((a >> 2) == 2) ? ti0[2] : ti0[3];
            const unsigned wb = ((bq >> 2) == 0) ? ti1[0] : ((bq >> 2) == 1) ? ti1[1] : ((bq >> 2) == 2) ? ti1[2] : ti1[3];
            const int ia = (wa >> (8 * (a & 3))) & 255, ib = (wb >> (8 * (bq & 3))) & 255;
            oi[q] = ia * 128 + ib;
            og[q] = __expf(bsv - bs[0]) * inv;
        }
        *(int4*)(seli + (size_t)(t0 + li) * 128 + hh * 16 + 4 * g) = make_int4(oi[0], oi[1], oi[2], oi[3]);
        *(float4*)(selg + (size_t)(t0 + li) * 128 + hh * 16 + 4 * g) = make_float4(og[0], og[1], og[2], og[3]);
    }
}

__device__ __forceinline__ unsigned pack4_fp8(float a, float b, float c, float d, float sc) {
    int w = 0;
    w = __builtin_amdgcn_cvt_pk_fp8_f32(fminf(fmaxf(a * sc, -448.f), 448.f), fminf(fmaxf(b * sc, -448.f), 448.f), w, false);
    w = __builtin_amdgcn_cvt_pk_fp8_f32(fminf(fmaxf(c * sc, -448.f), 448.f), fminf(fmaxf(d * sc, -448.f), 448.f), w, true);
    return (unsigned)w;
}
__device__ __forceinline__ void phase_peer_convert(const Ctx& X, const Params& p, int L) {
    const float4* su = (const float4*)(p.peer_u + (size_t)L * NEXP * 1024);
    const float4* sv = (const float4*)(p.peer_v + (size_t)L * NEXP * 1024);
    u32x4* du = (u32x4*)(p.ws + OFF_PU);
    u32x4* dv = (u32x4*)(p.ws + OFF_PV);
    for (size_t e = (size_t)X.bid * NT + X.tid; e < (size_t)NEXP * 64; e += (size_t)X.nb * NT) {
        u32x4 o1, o2;
#pragma unroll
        for (int q = 0; q < 4; ++q) {
            const float4 a = su[4 * e + q], bq = sv[4 * e + q];
            o1[q] = pack4_fp8(a.x, a.y, a.z, a.w, 512.f);
            o2[q] = pack4_fp8(bq.x, bq.y, bq.z, bq.w, 128.f);
        }
        du[e] = o1;
        dv[e] = o2;
    }
}

__device__ __forceinline__ void phase_peer_apply(const Ctx& X, const Params& p, int L, char* smem, bool dry = false) {
    const int tid = X.tid, lane = tid & 63, w = tid >> 6, li = lane & 15, g = lane >> 4;
    unsigned char* sX = (unsigned char*)smem + w * 1024;
    const u16* hn = (const u16*)(p.ws + OFF_HN);
    const int* seli = (const int*)(p.ws + OFF_SELI);
    const float* selg = (const float*)(p.ws + OFF_SELG);
    float* h = (float*)(p.ws + (dry ? OFF_XQ : OFF_H));
    const unsigned char* PU = (const unsigned char*)(p.ws + OFF_PU);
    const unsigned char* PV = (const unsigned char*)(p.ws + OFF_PV);
    const int nIter = (T_ + X.nb * NW - 1) / (X.nb * NW);
    for (int tt = 0; tt < nIter; ++tt) {
        const int t = (tt * X.nb + X.bid) * NW + w;
        const bool act_t = t < T_;
        const int tc = act_t ? t : T_ - 1;
        __syncthreads();
        {
            const u32x4 x0 = *(const u32x4*)(hn + (size_t)tc * 1024 + lane * 16);
            const u32x4 x1 = *(const u32x4*)(hn + (size_t)tc * 1024 + lane * 16 + 8);
            u32x4 o;
            o[0] = pack4_fp8(__uint_as_float(x0[0] << 16), __uint_as_float(x0[0] & 0xffff0000u),
                             __uint_as_float(x0[1] << 16), __uint_as_float(x0[1] & 0xffff0000u), 16.f);
            o[1] = pack4_fp8(__uint_as_float(x0[2] << 16), __uint_as_float(x0[2] & 0xffff0000u),
                             __uint_as_float(x0[3] << 16), __uint_as_float(x0[3] & 0xffff0000u), 16.f);
            o[2] = pack4_fp8(__uint_as_float(x1[0] << 16), __uint_as_float(x1[0] & 0xffff0000u),
                             __uint_as_float(x1[1] << 16), __uint_as_float(x1[1] & 0xffff0000u), 16.f);
            o[3] = pack4_fp8(__uint_as_float(x1[2] << 16), __uint_as_float(x1[2] & 0xffff0000u),
                             __uint_as_float(x1[3] << 16), __uint_as_float(x1[3] & 0xffff0000u), 16.f);
            *(u32x4*)(sX + lane * 16) = o;
        }
        __syncthreads();
        float y[16];
#pragma unroll
        for (int i = 0; i < 16; ++i) y[i] = 0.f;
#pragma unroll 1
        for (int gr = 0; gr < 8; ++gr) {
            const int idx = seli[(size_t)tc * 128 + gr * 16 + li];
            const f32x4 gate = *(const f32x4*)(selg + (size_t)tc * 128 + gr * 16 + 4 * g);
            const unsigned char* urow = PU + (size_t)idx * 1024 + g * 256;
            f32x4 acc = f32x4{0.f, 0.f, 0.f, 0.f};
#pragma unroll 8
            for (int kk = 0; kk < 16; ++kk) {
                union { u32x4 v; long l[2]; } a, bx;
                a.v = *(const u32x4*)(urow + kk * 16);
                bx.v = *(const u32x4*)(sX + g * 256 + kk * 16);
                acc = __builtin_amdgcn_mfma_f32_16x16x32_fp8_fp8(a.l[0], bx.l[0], acc, 0, 0, 0);
                acc = __builtin_amdgcn_mfma_f32_16x16x32_fp8_fp8(a.l[1], bx.l[1], acc, 0, 0, 0);
            }
            float actv[4];
#pragma unroll
            for (int j = 0; j < 4; ++j) {
                const float a = acc[j] * (1.f / 8192.f);
                actv[j] = 0.5f * a * (1.f + erff(a * 0.70710678118654752f)) * gate[j] * (1.f / 128.f);
            }
#pragma unroll 1
            for (int eh = 0; eh < 2; ++eh) {
#pragma unroll
                for (int e8 = 0; e8 < 8; ++e8) {
                    const float ae = __int_as_float(__builtin_amdgcn_readlane(__float_as_int(actv[e8 & 3]), 16 * (2 * eh + (e8 >> 2))));
                    const int ie = __builtin_amdgcn_readlane(idx, eh * 8 + e8);
                    const u32x4 v = *(const u32x4*)(PV + (size_t)ie * 1024 + lane * 16);
#pragma unroll
                    for (int q = 0; q < 4; ++q) {
                        const f32v2 lo = __builtin_amdgcn_cvt_pk_f32_fp8((int)v[q], false);
                        const f32v2 hi = __builtin_amdgcn_cvt_pk_f32_fp8((int)v[q], true);
                        y[4 * q] += ae * lo[0];
                        y[4 * q + 1] += ae * lo[1];
                        y[4 * q + 2] += ae * hi[0];
                        y[4 * q + 3] += ae * hi[1];
                    }
                }
            }
        }
        if (act_t) {
            float4* hr = (float4*)(h + (size_t)t * 1024 + lane * 16);
#pragma unroll
            for (int q = 0; q < 4; ++q) {
                float4 hv = hr[q];
                hv.x += y[4 * q]; hv.y += y[4 * q + 1]; hv.z += y[4 * q + 2]; hv.w += y[4 * q + 3];
                hr[q] = hv;
            }
        }
    }
}

#define XB_TMO      128
#define XB_XCNT(j)  (256  + 64 * (j))
#define XB_XSUB(j)  (1280 + 64 * (j))
#define XB_XGEN(j)  (2304 + 64 * (j))
#define XB_TOP      3328
#define XB_TOPGEN   3392
#define XCD_BAR_WORDS 3456
#define XB_SPIN_CAP (1u << 27)
#define LAS __attribute__((address_space(3)))
__device__ __forceinline__ unsigned xb_ld(unsigned* p) { return __hip_atomic_load(p, __ATOMIC_RELAXED, __HIP_MEMORY_SCOPE_AGENT); }
__device__ __forceinline__ unsigned xb_add(unsigned* p, unsigned v) { return __hip_atomic_fetch_add(p, v, __ATOMIC_RELAXED, __HIP_MEMORY_SCOPE_AGENT); }
__device__ __forceinline__ unsigned xb_xcc_id() { return (unsigned)__builtin_amdgcn_s_getreg((3 << 11) | 20) & 0xFu; }
#define XB_SPIN(cond, bar) do { unsigned _sp = 0; while (cond) { __builtin_amdgcn_s_sleep(1); \
    if ((++_sp & 255u) == 0u) { if (xb_ld(&(bar)[XB_TMO])) break; if (_sp > XB_SPIN_CAP) { atomicAdd(&(bar)[XB_TMO], 1u); break; } } } } while (0)
struct XcdBarrier {
    unsigned* bar; unsigned x;
    volatile LAS unsigned* st;
};
__device__ __forceinline__ XcdBarrier xcd_barrier_post(unsigned* bar, volatile LAS unsigned* st) {
    XcdBarrier b; b.bar = bar; b.x = xb_xcc_id(); b.st = st;
    if (threadIdx.x == 0) (void)xb_add(&bar[XB_XCNT(b.x)], 1u);
    return b;
}
__device__ __forceinline__ void xcd_barrier_complete(unsigned* bar, unsigned x, unsigned& nloc, unsigned& nx) {
    const unsigned G = gridDim.x * gridDim.y * gridDim.z;
    unsigned sum, cnt, mine, sp = 0u;
    for (;;) {
        sum = 0u; cnt = 0u; mine = 0u;
#pragma unroll
        for (unsigned j = 0; j < 16; ++j) { const unsigned c = xb_ld(&bar[XB_XCNT(j)]); sum += c; cnt += (c > 0u) ? 1u : 0u; mine = (j == x) ? c : mine; }
        if (sum == G) break;
        __builtin_amdgcn_s_sleep(1);
        if ((++sp & 255u) == 0u) { if (xb_ld(&bar[XB_TMO])) break; if (sp > XB_SPIN_CAP) { atomicAdd(&bar[XB_TMO], 1u); break; } }
    }
    nloc = mine > 0u ? mine : 1u; nx = cnt > 0u ? cnt : 1u;
}
__device__ __forceinline__ void xcd_barrier(const XcdBarrier& b) {
    asm volatile("s_waitcnt vmcnt(0)" ::: "memory");
    __syncthreads();
    if (threadIdx.x == 0) {
        unsigned* bar = b.bar;
        __builtin_amdgcn_s_waitcnt(0);
        unsigned nloc = b.st[0], nx = b.st[1];
        if (nloc == 0u) { xcd_barrier_complete(bar, b.x, nloc, nx); b.st[0] = nloc; b.st[1] = nx; }
        const unsigned old = xb_add(&bar[XB_XSUB(b.x)], 1u);
        const unsigned gen = old / nloc;
        if (old + 1u == (gen + 1u) * nloc) {
            __builtin_amdgcn_fence(__ATOMIC_RELEASE, "agent");
            asm volatile("s_waitcnt vmcnt(0)" ::: "memory");
            const unsigned og = xb_add(&bar[XB_TOP], 1u);
            const unsigned tg = og / nx;
            if (og + 1u == (tg + 1u) * nx) xb_add(&bar[XB_TOPGEN], 1u);
            else XB_SPIN(xb_ld(&bar[XB_TOPGEN]) == tg, bar);
            __builtin_amdgcn_fence(__ATOMIC_ACQUIRE, "agent");
            xb_add(&bar[XB_XGEN(b.x)], 1u);
            asm volatile("s_waitcnt vmcnt(0)" ::: "memory");
        } else {
            XB_SPIN(xb_ld(&bar[XB_XGEN(b.x)]) == gen, bar);
            __builtin_amdgcn_fence(__ATOMIC_ACQUIRE, "agent");
            asm volatile("s_waitcnt vmcnt(0)" ::: "memory");
        }
    }
    __syncthreads();
}

enum { OP_PROLOGUE = 0, OP_XKV, OP_NORM1, OP_GEMM_PROJ, OP_KMEAN, OP_MIXERS, OP_SSDNORM, OP_MERGE, OP_GEMM_OUT, OP_NORM2,
       OP_GEMM_XQ, OP_XATTN, OP_GEMM_XO, OP_NORM3, OP_GEMM_PQ, OP_PSEL, OP_PAPPLY, OP_FINAL };
constexpr int N_PHASES = 2 + 2 * 15 + 1;

__device__ __forceinline__ void run_phase(const Ctx& X, const Params& p, int ph, char* smem) {
    char* ws = p.ws;
    int op, L = 0;
    if (ph < 2) op = ph;
    else if (ph == N_PHASES - 1) op = OP_FINAL;
    else { L = (ph - 2) / 15; op = OP_NORM1 + (ph - 2) % 15; }
    const char* wl = ws + OFF_W + L * W_LAYER;
    switch (op) {
    case OP_PROLOGUE: phase_prologue(X, p, smem); break;
    case OP_XKV:
        for (int l2 = 0; l2 < 2; ++l2)
            phase_gemm<EPI_BF16>(X, p, (const u16*)(ws + OFF_MEMB), 1024, (const u16*)(ws + OFF_W + l2 * W_LAYER + W_XKV),
                                 2048, 2048, 1024, (u16*)(ws + OFF_XKV) + (size_t)l2 * 2048 * 2048, 2048, smem);
        break;
    case OP_NORM1: phase_norm(X, p, p.mix_norm + L * 1024, (const float*)(ws + OFF_WDT) + L * 8 * 1024); break;
    case OP_GEMM_PROJ:
        phase_gemm<EPI_PROJ>(X, p, (const u16*)(ws + OFF_HN), 1024, (const u16*)(wl + W_IN), T_, NPROJ, 1024, ws + OFF_PROJ,
                             NPROJ, smem);
        break;
    case OP_KMEAN: phase_kmean(X, p); phase_premix(X, p, L); break;
    case OP_MIXERS: phase_mixers(X, p, L, smem); break;
    case OP_SSDNORM: phase_ssdnorm(X, p, L); phase_peer_convert(X, p, L); break;
    case OP_MERGE: phase_merge(X, p, L, smem); break;
    case OP_GEMM_OUT:
        phase_gemm<EPI_RESID>(X, p, (const u16*)(ws + OFF_MERGED), 1024, (const u16*)(wl + W_O), T_, 1024, 1024, ws + OFF_H,
                              1024, smem);
        break;
    case OP_NORM2: phase_norm(X, p, p.x_norm + L * 1024, nullptr); break;
    case OP_GEMM_XQ:
        phase_gemm<EPI_BF16>(X, p, (const u16*)(ws + OFF_HN), 1024, (const u16*)(wl + W_XQ), T_, 1024, 1024, ws + OFF_XQ,
                             1024, smem);
        break;
    case OP_XATTN: phase_xattn(X, p, L, smem); break;
    case OP_GEMM_XO:
        phase_gemm<EPI_RESID>(X, p, (const u16*)(ws + OFF_XO), 1024, (const u16*)(wl + W_XO), T_, 1024, 1024, ws + OFF_H,
                              1024, smem);
        break;
    case OP_NORM3: phase_norm(X, p, p.ffn_norm + L * 1024, nullptr); break;
    case OP_GEMM_PQ:
        phase_gemm<EPI_BF16>(X, p, (const u16*)(ws + OFF_HN), 1024, (const u16*)(wl + W_PQ), T_, 2048, 1024, ws + OFF_PQ,
                             2048, smem);
        break;
    case OP_PSEL: phase_peer_select(X, p, L); break;
    case OP_PAPPLY: phase_peer_apply(X, p, L, smem); break;
    default: phase_final(X, p); break;
    }
}

__device__ __forceinline__ int hw_wave_slot() { return (int)(__builtin_amdgcn_s_getreg(((6 - 1) << 11) | 4) & 63u); }

__global__ void __launch_bounds__(512, 2) mk_kernel(Params p, int ph_lo, int ph_hi) {
    cg::grid_group grid = cg::this_grid();
    __shared__ __attribute__((aligned(16))) char smem[SMEM_BYTES];
    volatile LAS int* sWave = (volatile LAS int*)(smem + SMEM_BYTES - 512);
    if ((threadIdx.x & 63) == 0) sWave[hw_wave_slot()] = threadIdx.x >> 6;
    if (threadIdx.x == 0) *(uint4*)(smem + SMEM_BYTES - 16) = make_uint4(0u, 0u, 0u, 0u);
    __syncthreads();
    const XcdBarrier xb = xcd_barrier_post((unsigned*)(p.ws + OFF_BAR), (volatile LAS unsigned*)(smem + SMEM_BYTES - 16));
#pragma unroll 1
    for (int ph = ph_lo; ph < ph_hi; ++ph) {
        Ctx X;
        {
            unsigned zz = 0u;
            asm volatile("" : "+s"(zz));
            const int lane = __builtin_amdgcn_mbcnt_hi(~0u, __builtin_amdgcn_mbcnt_lo(~0u, zz));
            int widx = sWave[hw_wave_slot()];
            widx = __builtin_amdgcn_readfirstlane(widx);
            X.tid = widx * 64 + lane;
        }
        X.bid = blockIdx.x; X.nb = gridDim.x;
        asm volatile("" : "+v"(X.tid));
        asm volatile("" : "+s"(X.bid));
        asm volatile("" : "+s"(X.nb));
        Params q = p;
        {
            long z = 0;
            asm volatile("" : "+s"(z));
            const char** qq = (const char**)&q;
#pragma unroll
            for (int i = 0; i < 25; ++i) qq[i] += z;
        }
        run_phase(X, q, ph, smem);
#ifdef REP_OP
        if (ph == REP_OP) {
            for (int rep = 0; rep < REP_N; ++rep) {
                xcd_barrier(xb);
                if (REP_OP == 2 + OP_PAPPLY - OP_NORM1) phase_peer_apply(X, q, 0, smem, true);
                else run_phase(X, q, ph, smem);
            }
        }
#endif
        if (ph + 1 < ph_hi) {
            if (ph == ph_lo) grid.sync();
            else xcd_barrier(xb);
        }
    }
}

extern "C" void kernel_launch(void* const* d_in, const int* in_sizes, int n_in, void* d_out, int out_size, void* d_ws,
                              size_t ws_size, hipStream_t stream) {
    static int grid_blocks = 0;
    if (!grid_blocks) {
        int dev = 0, cus = 0, per_cu = 0;
        (void)hipGetDevice(&dev);
        (void)hipDeviceGetAttribute(&cus, hipDeviceAttributeMultiprocessorCount, dev);
        (void)hipOccupancyMaxActiveBlocksPerMultiprocessor(&per_cu, mk_kernel, NT, 0);
        if (per_cu > 1) per_cu = 1;
        if (per_cu < 1) per_cu = 1;
        grid_blocks = cus * per_cu;
    }
    Params p{};
    const float** pp = (const float**)&p;
    for (int i = 0; i < 23; ++i) pp[i] = (const float*)d_in[i];
    p.out = (float*)d_out;
    p.ws = (char*)d_ws;
    if (ws_size < 512 * MiB) fprintf(stderr, "workspace too small: %zu\n", ws_size);
    int ph_lo = 0, ph_hi = N_PHASES;
    (void)hipMemsetAsync((char*)d_ws + OFF_BAR, 0, 16384, stream);
    void* args[] = {&p, &ph_lo, &ph_hi};
    hipError_t e = hipLaunchCooperativeKernel((void*)mk_kernel, dim3(grid_blocks), dim3(NT), args, 0, stream);
    if (e != hipSuccess) fprintf(stderr, "cooperative launch failed: %s (grid %d)\n", hipGetErrorString(e), grid_blocks);
}
```
